# Optimizing an MI355X kernel written in HIP

```python
import math
import jax
import jax.numpy as jnp
from jax import lax
import numpy as np

D_MODEL = 1024
BATCH = 2
SEQ = 16384
DEPTH = 4

GRID_W = 64
CTX_LEN = 256
D_FF = 2816
N_MOD = 9
NORM_EPS = 1e-6
NA_HEADS = 8
NA_HEAD_DIM = 32
NA_ROWS = 8
NA_COLS = 16
RET_HEADS = 4
RET_QK_DIM = 64
RET_V_DIM = 128
RET_CHUNK = 128
ROPE_BASE = 10000.0
S5_GROUPS = 16
S5_GROUP_CH = 16
S5_STATE = 64
NA_WIDTH = NA_HEADS * NA_HEAD_DIM
RET_QK_WIDTH = RET_HEADS * RET_QK_DIM
RET_V_WIDTH = RET_HEADS * RET_V_DIM
S5_WIDTH = S5_GROUPS * S5_GROUP_CH
MIX_WIDTH = NA_WIDTH + RET_V_WIDTH + S5_WIDTH
IN_SPLITS = (NA_WIDTH, NA_WIDTH, NA_WIDTH, RET_QK_WIDTH, RET_QK_WIDTH, RET_V_WIDTH, RET_V_WIDTH, S5_WIDTH)
IN_WIDTH = sum(IN_SPLITS)

kernel_name = "hybrid_natten_retnet_s5_macaron_block"


def rms_norm(x):
    xf = x.astype(jnp.float32)
    return (xf * lax.rsqrt(jnp.mean(xf * xf, axis=-1, keepdims=True) + NORM_EPS)).astype(x.dtype)


def modulate(h, shift, scale):
    return h * (1 + scale) + shift


def swiglu(h, w_in, w_out):
    a, b = jnp.split(h @ w_in, 2, axis=-1)
    return (jax.nn.silu(a) * b) @ w_out


def to_heads(z, n_heads):
    b, t, _ = z.shape
    return z.reshape(b, t, n_heads, -1).transpose(0, 2, 1, 3)


def from_heads(z):
    b, h, t, d = z.shape
    return z.transpose(0, 2, 1, 3).reshape(b, t, h * d)


def axial_rope(z):
    n, d = z.shape[-2], z.shape[-1]
    nf = d // 4
    inv = ROPE_BASE ** (-jnp.arange(nf, dtype=jnp.float32) / nf)
    t = jnp.arange(n)
    row = (t // GRID_W).astype(jnp.float32)
    col = (t % GRID_W).astype(jnp.float32)
    ang = jnp.concatenate([row[:, None] * inv, col[:, None] * inv], axis=-1)
    cos = jnp.cos(ang).astype(z.dtype)
    sin = jnp.sin(ang).astype(z.dtype)
    z1, z2 = jnp.split(z, 2, axis=-1)
    return jnp.concatenate([z1 * cos - z2 * sin, z1 * sin + z2 * cos], axis=-1)


def neighborhood_attention(q, k, v, kc, vc, rpb, rows):
    b, h, n, dh = q.shape
    kr = min(NA_ROWS, rows)
    qg = q.reshape(b, h, rows, GRID_W, dh)
    kg = k.reshape(b, h, rows, GRID_W, dh)
    vg = v.reshape(b, h, rows, GRID_W, dh)
    col_start = np.clip(np.arange(GRID_W) - NA_COLS // 2, 0, GRID_W - NA_COLS)
    col_idx = col_start[:, None] + np.arange(NA_COLS)[None, :]
    col_off = col_idx - np.arange(GRID_W)[:, None] + NA_COLS - 1
    scale = dh ** -0.5
    n_loc = kr * NA_COLS

    def one_row(r):
        rs = jnp.clip(r - kr // 2, 0, rows - kr)
        k_win = lax.dynamic_slice_in_dim(kg, rs, kr, axis=2)[:, :, :, col_idx]
        v_win = lax.dynamic_slice_in_dim(vg, rs, kr, axis=2)[:, :, :, col_idx]
        q_row = lax.dynamic_index_in_dim(qg, r, axis=2, keepdims=False)
        row_off = rs + jnp.arange(kr) - r + NA_ROWS - 1
        bias = jnp.transpose(rpb[:, row_off][:, :, col_off], (0, 2, 1, 3))
        s_loc = jnp.einsum('bhwd,bhiwjd->bhwij', q_row, k_win).astype(jnp.float32) * scale
        s_loc = s_loc + bias[None].astype(jnp.float32)
        s_ctx = jnp.einsum('bhwd,bhld->bhwl', q_row, kc).astype(jnp.float32) * scale
        s = jnp.concatenate([s_loc.reshape(b, h, GRID_W, n_loc), s_ctx], axis=-1)
        p = jax.nn.softmax(s, axis=-1).astype(v.dtype)
        p_loc = p[..., :n_loc].reshape(b, h, GRID_W, kr, NA_COLS)
        p_ctx = p[..., n_loc:]
        return (jnp.einsum('bhwij,bhiwjd->bhwd', p_loc, v_win)
                + jnp.einsum('bhwl,bhld->bhwd', p_ctx, vc))

    out = lax.map(one_row, jnp.arange(rows))
    return jnp.transpose(out, (1, 0, 3, 2, 4)).reshape(b, n, h * dh)


def context_attention(qc, kc, vc):
    scale = qc.shape[-1] ** -0.5
    s = jnp.einsum('bhqd,bhkd->bhqk', qc, kc).astype(jnp.float32) * scale
    p = jax.nn.softmax(s, axis=-1).astype(vc.dtype)
    return from_heads(jnp.einsum('bhqk,bhkd->bhqd', p, vc))


def retention_chunkwise(q, k, v, log_g, s0, inclusive):
    f32 = jnp.float32
    b, h, t, dk = q.shape
    dv = v.shape[-1]
    nc = t // RET_CHUNK
    qc = q.astype(f32).reshape(b, h, nc, RET_CHUNK, dk)
    kc = k.astype(f32).reshape(b, h, nc, RET_CHUNK, dk)
    vc = v.astype(f32).reshape(b, h, nc, RET_CHUNK, dv)
    pos = jnp.arange(RET_CHUNK, dtype=f32)
    diff = pos[:, None] - pos[None, :]
    mask = (diff >= 0) if inclusive else (diff > 0)
    lg = log_g[:, None, None]
    dmat = jnp.where(mask, jnp.exp(lg * jnp.where(mask, diff, 0.0)), 0.0)
    scores = jnp.einsum('bhnid,bhnjd->bhnij', qc, kc) * dmat[None, :, None]
    o_intra = jnp.einsum('bhnij,bhnjv->bhniv', scores, vc)
    w_end = jnp.exp(log_g[:, None] * (RET_CHUNK - 1 - pos))
    kv = jnp.einsum('bhnjd,hj,bhnjv->bhndv', kc, w_end, vc)
    g_chunk = jnp.exp(log_g * RET_CHUNK)[:, None, None]
    if s0 is None:
        s0 = jnp.zeros((b, h, dk, dv), f32)

    def step(s, kv_n):
        return g_chunk * s + kv_n, s

    s_last, s_prev = lax.scan(step, s0.astype(f32), jnp.moveaxis(kv, 2, 0))
    w_in = jnp.exp(log_g[:, None] * (pos + 1.0))
    o_cross = jnp.einsum('bhnid,nbhdv->bhniv', qc, s_prev) * w_in[None, :, None, :, None]
    return (o_intra + o_cross).reshape(b, h, t, dv), s_last


def retention_final_state(k, v, log_g):
    t = k.shape[2]
    w = jnp.exp(log_g[:, None] * (t - 1 - jnp.arange(t, dtype=jnp.float32)))
    return jnp.einsum('bhtd,ht,bhtv->bhdv', k.astype(jnp.float32), w, v.astype(jnp.float32))


def retention_output(o, gate, gn_gain):
    mu = jnp.mean(o, axis=-1, keepdims=True)
    var = jnp.mean(jnp.square(o - mu), axis=-1, keepdims=True)
    o = from_heads((o - mu) * lax.rsqrt(var + NORM_EPS)) * gn_gain.astype(jnp.float32)
    return (jax.nn.silu(gate.astype(jnp.float32)) * o).astype(gate.dtype)


def retention_mixer(q, k, v, gate, qc, kc, vc, gate_c, decay, gn_gain, need_ctx):
    log_g = jax.nn.log_sigmoid(decay.astype(jnp.float32))
    flip = lambda z: jnp.flip(z, axis=2)
    y_ctx = None
    if need_ctx:
        oc_f, s_f = retention_chunkwise(qc, kc, vc, log_g[0], None, True)
        oc_b, s_b = retention_chunkwise(flip(qc), flip(kc), flip(vc), log_g[1], None, False)
        y_ctx = retention_output(oc_f + flip(oc_b), gate_c, gn_gain)
    else:
        s_f = retention_final_state(kc, vc, log_g[0])
        s_b = retention_final_state(flip(kc), flip(vc), log_g[1])
    o_f, _ = retention_chunkwise(q, k, v, log_g[0], s_f, True)
    o_b, _ = retention_chunkwise(flip(q), flip(k), flip(v), log_g[1], s_b, False)
    y = retention_output(o_f + flip(o_b), gate, gn_gain)
    return y, y_ctx


def s5_discretize(a_re, a_im, log_dt, b_re, b_im):
    f32 = jnp.float32
    a_re = jnp.minimum(a_re.astype(f32), -1e-4)
    a_im = a_im.astype(f32)
    dt = jnp.exp(log_dt.astype(f32))[..., None]
    mag = jnp.exp(dt * a_re)
    ab_re = mag * jnp.cos(dt * a_im)
    ab_im = mag * jnp.sin(dt * a_im)
    den = a_re * a_re + a_im * a_im
    nr = ab_re - 1.0
    f_re = ((nr * a_re + ab_im * a_im) / den)[..., None]
    f_im = ((ab_im * a_re - nr * a_im) / den)[..., None]
    br = b_re.astype(f32)[None]
    bi = b_im.astype(f32)[None]
    bb_re = f_re * br - f_im * bi
    bb_im = f_re * bi + f_im * br
    return ab_re, ab_im, bb_re, bb_im


def _ssm_combine(e1, e2):
    ar1, ai1, br1, bi1 = e1
    ar2, ai2, br2, bi2 = e2
    return (ar1 * ar2 - ai1 * ai2,
            ar1 * ai2 + ai1 * ar2,
            ar2 * br1 - ai2 * bi1 + br2,
            ar2 * bi1 + ai2 * br1 + bi2)


def s5_scan(u, ab_re, ab_im, bb_re, bb_im, s0_re, s0_im):
    bu_re = jnp.einsum('tbgc,gpc->tbgp', u, bb_re)
    bu_im = jnp.einsum('tbgc,gpc->tbgp', u, bb_im)
    if s0_re is not None:
        bu_re = bu_re.at[0].add(ab_re * s0_re - ab_im * s0_im)
        bu_im = bu_im.at[0].add(ab_re * s0_im + ab_im * s0_re)
    shape = (u.shape[0], 1) + ab_re.shape
    a_re = jnp.broadcast_to(ab_re, shape)
    a_im = jnp.broadcast_to(ab_im, shape)
    _, _, x_re, x_im = lax.associative_scan(_ssm_combine, (a_re, a_im, bu_re, bu_im), axis=0)
    return x_re, x_im


def s5_readout(x_re, x_im, c_re, c_im):
    return (jnp.einsum('tbgp,gcp->tbgc', x_re, c_re.astype(jnp.float32))
            - jnp.einsum('tbgp,gcp->tbgc', x_im, c_im.astype(jnp.float32)))


def s5_glu(y, w_glu):
    a, g = jnp.split(jax.nn.gelu(y).astype(w_glu.dtype) @ w_glu, 2, axis=-1)
    return a * jax.nn.sigmoid(g)


def s5_mixer(u, uc, a_re, a_im, log_dt, b_re, b_im, c_re, c_im, d, w_glu, need_ctx):
    b, n, _ = u.shape
    l = uc.shape[1]
    ut = u.astype(jnp.float32).reshape(b, n, S5_GROUPS, S5_GROUP_CH).transpose(1, 0, 2, 3)
    uct = uc.astype(jnp.float32).reshape(b, l, S5_GROUPS, S5_GROUP_CH).transpose(1, 0, 2, 3)
    ab_re, ab_im, bb_re, bb_im = s5_discretize(a_re, a_im, log_dt, b_re, b_im)
    d_gc = d.astype(jnp.float32).reshape(S5_GROUPS, S5_GROUP_CH)
    y = ut * d_gc
    y_c = uct * d_gc if need_ctx else None
    for dn in range(2):
        fl = (lambda z: jnp.flip(z, axis=0)) if dn == 1 else (lambda z: z)
        xc_re, xc_im = s5_scan(fl(uct), ab_re[dn], ab_im[dn], bb_re[dn], bb_im[dn], None, None)
        x_re, x_im = s5_scan(fl(ut), ab_re[dn], ab_im[dn], bb_re[dn], bb_im[dn], xc_re[-1], xc_im[-1])
        y = y + fl(s5_readout(x_re, x_im, c_re[dn], c_im[dn]))
        if need_ctx:
            y_c = y_c + fl(s5_readout(xc_re, xc_im, c_re[dn], c_im[dn]))
    out = s5_glu(y.transpose(1, 0, 2, 3).reshape(b, n, S5_WIDTH), w_glu).astype(u.dtype)
    out_c = None
    if need_ctx:
        out_c = s5_glu(y_c.transpose(1, 0, 2, 3).reshape(b, l, S5_WIDTH), w_glu).astype(u.dtype)
    return out, out_c


def token_mixing(h, hc, w_in, na_q_gain, na_k_gain, na_rpb, ret_decay, ret_gn,
                 s5_a_re, s5_a_im, s5_log_dt, s5_b_re, s5_b_im, s5_c_re, s5_c_im, s5_d, s5_w_glu,
                 need_ctx):
    rows = h.shape[1] // GRID_W
    cuts = [int(v) for v in np.cumsum(IN_SPLITS)[:-1]]
    qa, ka, va, qb, kb, vb, gb, ub = jnp.split(h @ w_in, cuts, axis=-1)
    qa_c, ka_c, va_c, qb_c, kb_c, vb_c, gb_c, ub_c = jnp.split(hc @ w_in, cuts, axis=-1)

    qk_norm = lambda z, g: rms_norm(to_heads(z, NA_HEADS)) * g
    k_ac = qk_norm(ka_c, na_k_gain)
    v_ac = to_heads(va_c, NA_HEADS)
    y_a = neighborhood_attention(qk_norm(qa, na_q_gain), qk_norm(ka, na_k_gain),
                                 to_heads(va, NA_HEADS), k_ac, v_ac, na_rpb, rows)

    k_scale = RET_QK_DIM ** -0.5
    q_b = axial_rope(to_heads(qb, RET_HEADS))
    k_b = axial_rope(to_heads(kb, RET_HEADS)) * k_scale
    y_b, y_b_c = retention_mixer(q_b, k_b, to_heads(vb, RET_HEADS), gb,
                                 to_heads(qb_c, RET_HEADS), to_heads(kb_c, RET_HEADS) * k_scale,
                                 to_heads(vb_c, RET_HEADS), gb_c, ret_decay, ret_gn, need_ctx)

    y_c, y_c_c = s5_mixer(ub, ub_c, s5_a_re, s5_a_im, s5_log_dt, s5_b_re, s5_b_im,
                          s5_c_re, s5_c_im, s5_d, s5_w_glu, need_ctx)

    y = jnp.concatenate([y_a.astype(h.dtype), y_b.astype(h.dtype), y_c.astype(h.dtype)], axis=-1)
    y_ctx = None
    if need_ctx:
        y_a_c = context_attention(qk_norm(qa_c, na_q_gain), k_ac, v_ac)
        y_ctx = jnp.concatenate([y_a_c.astype(h.dtype), y_b_c.astype(h.dtype), y_c_c.astype(h.dtype)], axis=-1)
    return y, y_ctx


def setup_inputs(seed: int = 0) -> dict:
    key = jax.random.key(seed)
    ks = iter(jax.random.split(key, 32))
    f32 = jnp.float32
    D = D_MODEL

    def nrm(shape, s):
        return jax.random.normal(next(ks), shape, f32) * s

    x = nrm((BATCH, SEQ, D), 1.0)
    c = nrm((BATCH, D), 1.0)
    ctx = nrm((BATCH, CTX_LEN, D), 1.0)
    c_ctx = nrm((D,), 1.0)
    w_mod = nrm((DEPTH, D, N_MOD * D), 0.5 * D ** -0.5)
    b_mod = nrm((DEPTH, N_MOD * D), 0.02)
    ffn1_w_in = nrm((DEPTH, D, 2 * D_FF), D ** -0.5)
    ffn1_w_out = nrm((DEPTH, D_FF, D), D_FF ** -0.5)
    w_in = nrm((DEPTH, D, IN_WIDTH), D ** -0.5)
    w_out = nrm((DEPTH, MIX_WIDTH, D), MIX_WIDTH ** -0.5)
    na_q_gain = 1.0 + nrm((DEPTH, NA_HEAD_DIM), 0.05)
    na_k_gain = 1.0 + nrm((DEPTH, NA_HEAD_DIM), 0.05)
    na_rpb = nrm((DEPTH, NA_HEADS, 2 * NA_ROWS - 1, 2 * NA_COLS - 1), 0.2)
    ret_base = jnp.asarray(np.log(2.0 ** (5 + np.arange(RET_HEADS)) - 1.0), f32)
    ret_decay = ret_base + nrm((DEPTH, 2, RET_HEADS), 0.05)
    ret_gn = 1.0 + nrm((DEPTH, RET_V_WIDTH), 0.05)
    s5_a_re = -0.5 + nrm((DEPTH, 2, S5_GROUPS, S5_STATE), 0.01)
    s5_a_im = jnp.pi * jnp.arange(S5_STATE, dtype=f32) + nrm((DEPTH, 2, S5_GROUPS, S5_STATE), 0.01)
    s5_log_dt = jax.random.uniform(next(ks), (DEPTH, 2, S5_GROUPS), f32,
                                   minval=math.log(1e-3), maxval=math.log(1e-1))
    s5_b_re = nrm((DEPTH, S5_GROUPS, S5_STATE, S5_GROUP_CH), S5_GROUP_CH ** -0.5)
    s5_b_im = nrm((DEPTH, S5_GROUPS, S5_STATE, S5_GROUP_CH), S5_GROUP_CH ** -0.5)
    s5_c_re = nrm((DEPTH, 2, S5_GROUPS, S5_GROUP_CH, S5_STATE), S5_STATE ** -0.5)
    s5_c_im = nrm((DEPTH, 2, S5_GROUPS, S5_GROUP_CH, S5_STATE), S5_STATE ** -0.5)
    s5_d = nrm((DEPTH, S5_WIDTH), 0.5)
    s5_w_glu = nrm((DEPTH, S5_WIDTH, 2 * S5_WIDTH), S5_WIDTH ** -0.5)
    ffn2_w_in = nrm((DEPTH, D, 2 * D_FF), D ** -0.5)
    ffn2_w_out = nrm((DEPTH, D_FF, D), D_FF ** -0.5)
    return {"x": x, "c": c, "ctx": ctx, "c_ctx": c_ctx, "w_mod": w_mod, "b_mod": b_mod,
            "ffn1_w_in": ffn1_w_in, "ffn1_w_out": ffn1_w_out, "w_in": w_in, "w_out": w_out,
            "na_q_gain": na_q_gain, "na_k_gain": na_k_gain, "na_rpb": na_rpb,
            "ret_decay": ret_decay, "ret_gn": ret_gn,
            "s5_a_re": s5_a_re, "s5_a_im": s5_a_im, "s5_log_dt": s5_log_dt,
            "s5_b_re": s5_b_re, "s5_b_im": s5_b_im, "s5_c_re": s5_c_re, "s5_c_im": s5_c_im,
            "s5_d": s5_d, "s5_w_glu": s5_w_glu, "ffn2_w_in": ffn2_w_in, "ffn2_w_out": ffn2_w_out}


def reference(x, c, ctx, c_ctx, w_mod, b_mod, ffn1_w_in, ffn1_w_out, w_in, w_out,
              na_q_gain, na_k_gain, na_rpb, ret_decay, ret_gn,
              s5_a_re, s5_a_im, s5_log_dt, s5_b_re, s5_b_im, s5_c_re, s5_c_im, s5_d, s5_w_glu,
              ffn2_w_in, ffn2_w_out):
    xc = ctx
    sc = jax.nn.silu(c)[:, None, :]
    scc = jax.nn.silu(c_ctx)[None, None, :]
    for l in range(DEPTH):
        need_ctx = l < DEPTH - 1
        m = jnp.split(sc @ w_mod[l] + b_mod[l], N_MOD, axis=-1)
        mc = jnp.split(scc @ w_mod[l] + b_mod[l], N_MOD, axis=-1)
        x = x + 0.5 * m[2] * swiglu(modulate(rms_norm(x), m[0], m[1]), ffn1_w_in[l], ffn1_w_out[l])
        xc = xc + 0.5 * mc[2] * swiglu(modulate(rms_norm(xc), mc[0], mc[1]), ffn1_w_in[l], ffn1_w_out[l])
        y, y_ctx = token_mixing(modulate(rms_norm(x), m[3], m[4]), modulate(rms_norm(xc), mc[3], mc[4]),
                                w_in[l], na_q_gain[l], na_k_gain[l], na_rpb[l], ret_decay[l], ret_gn[l],
                                s5_a_re[l], s5_a_im[l], s5_log_dt[l], s5_b_re[l], s5_b_im[l],
                                s5_c_re[l], s5_c_im[l], s5_d[l], s5_w_glu[l], need_ctx)
        x = x + m[5] * (y @ w_out[l])
        x = x + 0.5 * m[8] * swiglu(modulate(rms_norm(x), m[6], m[7]), ffn2_w_in[l], ffn2_w_out[l])
        if need_ctx:
            xc = xc + mc[5] * (y_ctx @ w_out[l])
            xc = xc + 0.5 * mc[8] * swiglu(modulate(rms_norm(xc), mc[6], mc[7]), ffn2_w_in[l], ffn2_w_out[l])
    return x
```

```cpp
#include <hip/hip_runtime.h>
#include <hip/hip_cooperative_groups.h>
#include <cstdio>
#include <cstdint>
namespace cg = cooperative_groups;
namespace pg8 {
#define PG8_LAS __attribute__((address_space(3)))
typedef unsigned short bf16_t;
typedef short bf16x8 __attribute__((ext_vector_type(8)));
typedef float f32x4 __attribute__((ext_vector_type(4)));
typedef unsigned u32x4 __attribute__((ext_vector_type(4)));
constexpr int BM = 256, BK = 64, HALF = 128, HTB = HALF * BK * 2  , STAGE_BYTES = 8 * HTB, NXCD = 8, WGM = 8;

__host__ __device__ __forceinline__ int lds_byte(int r, int c) { const int st = (r >> 4) * 2 + (c >> 5), rr = r & 15, cc = c & 31, ob = rr * 64 + cc * 2; return st * 1024 + (ob ^ (((ob >> 9) & 1) << 5)); }
__host__ __device__ __forceinline__ void stage_rc(int b, int& R, int& C) { const int st = b / 1024, sb = b % 1024, swz = sb ^ (((sb >> 9) & 1) << 5); R = (st >> 1) * 16 + swz / 64; C = (st & 1) * 32 + (swz % 64) / 2; }
__host__ __device__ __forceinline__ int perm32(int rho) { const int n = rho >> 4, i = rho & 15; return 8 * (i >> 2) + 4 * n + (i & 3); }

struct Unit { int pm, pn, k0, nt, split; };
struct Gemm { const bf16_t* A; const bf16_t* Bt; int M, N, K; };

struct StaticOrder {
    int nM, nN, nwg, G, c;
    __host__ __device__ void init(int M, int N, int G_, int c_) { nM = M / BM; nN = N / BM; nwg = nM * nN; G = G_; c = c_; }
    __host__ __device__ bool next(int i, Unit& u) const {
        const long L = (long)i * G + c; if (L >= nwg) return false;
        int wgid = (int)L; { const int q = nwg / NXCD, r = nwg % NXCD, xcd = wgid % NXCD, off = wgid / NXCD; wgid = (xcd < r ? xcd * (q + 1) : r * (q + 1) + (xcd - r) * q) + off; }
        const int nig = WGM * nN, gid = wgid / nig, fm = gid * WGM, gsz = (nM - fm) < WGM ? (nM - fm) : WGM;
        u.pm = fm + ((wgid % nig) % gsz); u.pn = (wgid % nig) / gsz; return true;
    }
    __device__ __forceinline__ void a_ready(const Unit&) const {}
    __device__ __forceinline__ void done(const Unit&) const {}
};

__device__ __forceinline__ unsigned cvt_pk_bf16(float lo, float hi) { unsigned r; asm volatile("v_cvt_pk_bf16_f32 %0, %1, %2" : "=v"(r) : "v"(lo), "v"(hi)); return r; }
struct Order {
    int nN, nLat, G, c, ntK, split_nt, nch;
    int no_ctx;
    __device__ __forceinline__ void init(int N, int K, int G_, int c_, int split_nt_, int no_ctx_) { nN = N / BM; nLat = 128 * nN; G = G_; c = c_; ntK = K / BK; split_nt = split_nt_; nch = split_nt_ ? ntK / split_nt_ : 1; no_ctx = no_ctx_; }
    __device__ __forceinline__ bool next(int i, Unit& u) const {
        const long L = (long)i * G + c;
        if (L < nLat) {
            int wgid = (int)L; { const int nwg = nLat, q = nwg / NXCD, r = nwg % NXCD, xcd = wgid % NXCD, off = wgid / NXCD; wgid = (xcd < r ? xcd * (q + 1) : r * (q + 1) + (xcd - r) * q) + off; }
            const int nM = 128, nig = WGM * nN, gid = wgid / nig, fm = gid * WGM, gsz = (nM - fm) < WGM ? (nM - fm) : WGM;
            u.pm = fm + ((wgid % nig) % gsz); u.pn = (wgid % nig) / gsz; u.k0 = 0; u.nt = ntK; u.split = 0; return true;
        }
        const int j = (int)(L - nLat);
        if (no_ctx || j >= 2 * nN * nch) return false;
        const int tile = j / nch, ch = j - tile * nch;
        u.pm = 128 + tile / nN; u.pn = tile % nN; u.k0 = ch * split_nt * BK; u.nt = split_nt ? split_nt : ntK; u.split = split_nt ? 1 : 0; return true;
    }
    __device__ __forceinline__ void a_ready(const Unit&) const {}
    __device__ __forceinline__ void done(const Unit&) const {}
};
__device__ __forceinline__ float sigm(float x) { return __builtin_amdgcn_rcpf(1.f + __expf(-x)); }
struct EpiAny {
    static constexpr bool PERM = true, AFTER_DRAIN = false;
    int type, ldc, col_off; float coef; bf16_t* O;
    const float* xin_l; float* xout_l; const float* xin_c; float* xout_c; const float* gate; float* part;
    __device__ __forceinline__ void operator()(const f32x4 (&acc)[2][2][4][2], const Unit& u, int wr, int wc, int fr, int fq) const {
        if (type <= 1) {
            const int row0 = u.pm * BM + wr * 64 + fr; const int col0 = col_off + u.pn * HALF + wc * 32 + 8 * fq;
#pragma unroll
            for (int ai = 0; ai < 2; ++ai)
#pragma unroll
                for (int m = 0; m < 4; ++m) {
                    bf16_t* rowp = O + (size_t)(row0 + ai * HALF + m * 16) * ldc + col0;
                    float r[8];
#pragma unroll
                    for (int n = 0; n < 2; ++n)
#pragma unroll
                        for (int e = 0; e < 4; ++e) { const float a = acc[ai][0][m][n][e], b = acc[ai][1][m][n][e]; r[4 * n + e] = (type == 0) ? a * sigm(a) * b : a * sigm(b); }
                    u32x4 w; w.x = cvt_pk_bf16(r[0], r[1]); w.y = cvt_pk_bf16(r[2], r[3]); w.z = cvt_pk_bf16(r[4], r[5]); w.w = cvt_pk_bf16(r[6], r[7]);
                    *(u32x4*)rowp = w;
                }
        } else if (type == 2) {
            const int row0 = u.pm * BM + wr * 64 + fr; const int col0 = u.pn * BM + wc * 32 + 8 * fq;
#pragma unroll
            for (int ai = 0; ai < 2; ++ai)
#pragma unroll
                for (int m = 0; m < 4; ++m) {
                    bf16_t* rowp = O + (size_t)(row0 + ai * HALF + m * 16) * ldc + col0;
#pragma unroll
                    for (int bj = 0; bj < 2; ++bj) { const f32x4 v0 = acc[ai][bj][m][0], v1 = acc[ai][bj][m][1];
                        u32x4 w; w.x = cvt_pk_bf16(v0[0], v0[1]); w.y = cvt_pk_bf16(v0[2], v0[3]); w.z = cvt_pk_bf16(v1[0], v1[1]); w.w = cvt_pk_bf16(v1[2], v1[3]);
                        *(u32x4*)(rowp + bj * HALF) = w; }
                }
        } else {
            const bool isc = u.pm >= 128; const int mi = isc ? 2 : (u.pm >> 6);
            const size_t rbase = isc ? (size_t)(u.pm - 128) * 256 : (size_t)u.pm * 256;
            const float* xi = isc ? xin_c : xin_l; float* xo = isc ? xout_c : xout_l;
            const float* gv = gate + mi * 9216;
            const int row0 = wr * 64 + fr, col0 = u.pn * BM + wc * 32 + 8 * fq;
#pragma unroll
            for (int bj = 0; bj < 2; ++bj) {
                const int c = col0 + bj * HALF;
                const f32x4 g0 = *(const f32x4*)(gv + c) * coef, g1 = *(const f32x4*)(gv + c + 4) * coef;
#pragma unroll
                for (int ai = 0; ai < 2; ++ai) {
                    if (u.split) {
                        const int ch = u.k0 / (u.nt * BK);
#pragma unroll
                        for (int m = 0; m < 4; ++m) { float* dst = part + (size_t)ch * (512 * 1024) + (rbase + row0 + ai * HALF + m * 16) * 1024 + c;
                            *(f32x4*)dst = g0 * acc[ai][bj][m][0]; *(f32x4*)(dst + 4) = g1 * acc[ai][bj][m][1]; }
                    } else {
                        f32x4 xv[4][2];
#pragma unroll
                        for (int m = 0; m < 4; ++m) { const float* src = xi + (rbase + row0 + ai * HALF + m * 16) * 1024 + c; xv[m][0] = *(const f32x4*)src; xv[m][1] = *(const f32x4*)(src + 4); }
                        asm volatile("" ::: "memory");
#pragma unroll
                        for (int m = 0; m < 4; ++m) { float* dst = xo + (rbase + row0 + ai * HALF + m * 16) * 1024 + c;
                            *(f32x4*)dst = xv[m][0] + g0 * acc[ai][bj][m][0]; *(f32x4*)(dst + 4) = xv[m][1] + g1 * acc[ai][bj][m][1]; }
                    }
                }
            }
        }
    }
};
template <class Epi, class Sched, bool ALIGN_EPI = false, bool SP2 = false>
__device__ __forceinline__ void gemm_phase(PG8_LAS unsigned char* lds, const Gemm g, const Sched& S, const Epi& E, const int tid_in) {
    const int tid = tid_in, wid = __builtin_amdgcn_readfirstlane(tid >> 6), lane = tid & 63, wr = wid >> 2, wc = wid & 3, fr = lane & 15, fq = lane >> 4;
    const int K = g.K;
    unsigned voffA[2], voffB[2];
#pragma unroll
    for (int i = 0; i < 2; ++i) { int R, C; stage_rc(tid * 16 + i * 8192, R, C); const int Rb = Epi::PERM ? ((R & ~31) + perm32(R & 31)) : R;
        voffA[i] = (unsigned)(R * K + C) * 2u; voffB[i] = (unsigned)(Rb * K + C) * 2u; }
    const size_t kstep = (size_t)(BK * 2);
    const size_t hstep = (size_t)HALF * K * 2;
    const size_t tstep = 2 * hstep;
    const unsigned ldsw = (unsigned)wid * 1024u;
    const int aoff = lds_byte(wr * 64 + fr, fq * 8), boff = lds_byte(wc * 32 + fr, fq * 8);
#define PG8_SA(b, h) (((b) * 2 + (h)) * HTB)
#define PG8_SB(b, h) ((4 + (b) * 2 + (h)) * HTB)
#define PG8_STAGE(bufoff, gbase, voff) do { _Pragma("unroll") for (int _i = 0; _i < 2; ++_i) \
        __builtin_amdgcn_global_load_lds((const unsigned*)((const char*)(gbase) + (voff)[_i]), (PG8_LAS unsigned*)(lds + (bufoff) + ldsw + _i * 8192), 16, 0, 0); } while (0)
#define PG8_LDA(dst, b, h) do { _Pragma("unroll") for (int m = 0; m < 4; ++m) _Pragma("unroll") for (int k = 0; k < 2; ++k) dst[m][k] = *(const PG8_LAS bf16x8*)(lds + PG8_SA(b, h) + aoff + m * 2048 + k * 1024); } while (0)
#define PG8_LDB(dst, b, h) do { _Pragma("unroll") for (int n = 0; n < 2; ++n) _Pragma("unroll") for (int k = 0; k < 2; ++k) dst[n][k] = *(const PG8_LAS bf16x8*)(lds + PG8_SB(b, h) + boff + n * 2048 + k * 1024); } while (0)
#define PG8_MMA(ai, bj, At, Bt) do { __builtin_amdgcn_s_setprio(1); _Pragma("unroll") for (int m = 0; m < 4; ++m) _Pragma("unroll") for (int n = 0; n < 2; ++n) _Pragma("unroll") for (int k = 0; k < 2; ++k) \
        acc[ai][bj][m][n] = __builtin_amdgcn_mfma_f32_16x16x32_bf16(Bt[n][k], At[m][k], acc[ai][bj][m][n], 0, 0, 0); __builtin_amdgcn_s_setprio(0); } while (0)
#define PG8_WAIT_V(n) asm volatile("s_waitcnt vmcnt(" #n ")" ::: "memory")
#define PG8_WAIT_L(n) asm volatile("s_waitcnt lgkmcnt(" #n ")" ::: "memory")
#define PG8_BAR __builtin_amdgcn_s_barrier()
#define PG8_SCHED __builtin_amdgcn_sched_barrier(0)
    Unit cur, nxt; int ui = 0;
    if (!S.next(0, cur)) return;
    f32x4 acc[2][2][4][2];
#pragma unroll
    for (int a = 0; a < 2; ++a)
#pragma unroll
        for (int b = 0; b < 2; ++b)
#pragma unroll
            for (int m = 0; m < 4; ++m)
#pragma unroll
                for (int n = 0; n < 2; ++n) acc[a][b][m][n] = (f32x4){0.f, 0.f, 0.f, 0.f};
    bf16x8 At[4][2], B0[2][2], B1[2][2];
    const char* cA = (const char*)g.A + (size_t)cur.pm * tstep + (size_t)cur.k0 * 2; const char* cB = (const char*)g.Bt + (size_t)cur.pn * tstep + (size_t)cur.k0 * 2;
    S.a_ready(cur);
    if constexpr (SP2) {
        PG8_STAGE(PG8_SB(0, 0), cB, voffB); PG8_STAGE(PG8_SB(0, 1), cB + hstep, voffB); PG8_STAGE(PG8_SA(0, 0), cA, voffA); PG8_STAGE(PG8_SA(0, 1), cA + hstep, voffA);
        if (wr == 1) PG8_BAR;
        PG8_WAIT_V(2); PG8_BAR;
        PG8_STAGE(PG8_SB(1, 0), cB + kstep, voffB); PG8_STAGE(PG8_SA(1, 0), cA + kstep, voffA); PG8_STAGE(PG8_SB(1, 1), cB + hstep + kstep, voffB);
        PG8_WAIT_V(6); PG8_BAR;
    } else {
        PG8_STAGE(PG8_SB(0, 0), cB, voffB); PG8_STAGE(PG8_SA(0, 0), cA, voffA); PG8_STAGE(PG8_SB(0, 1), cB + hstep, voffB); PG8_STAGE(PG8_SA(0, 1), cA + hstep, voffA);
        if (wr == 1) PG8_BAR;
        PG8_WAIT_V(4); PG8_BAR;
        PG8_STAGE(PG8_SB(1, 0), cB + kstep, voffB); PG8_STAGE(PG8_SA(1, 0), cA + kstep, voffA); PG8_STAGE(PG8_SB(1, 1), cB + hstep + kstep, voffB);
        PG8_WAIT_V(6); PG8_BAR;
    }
    for (;;) {
        const bool has_next = S.next(ui + 1, nxt);
        const char* nA = has_next ? (const char*)g.A + (size_t)nxt.pm * tstep + (size_t)nxt.k0 * 2 : cA; const char* nB = has_next ? (const char*)g.Bt + (size_t)nxt.pn * tstep + (size_t)nxt.k0 * 2 : cB;
        const int nt = cur.nt;
        for (int t = 0; t < nt; t += 2) {
            const bool last = (t == nt - 2);
            const char* a1 = cA + (size_t)(t + 1) * kstep;
            const char* a2 = last ? nA : cA + (size_t)(t + 2) * kstep; const char* b2 = last ? nB : cB + (size_t)(t + 2) * kstep;
            const char* a3 = a2 + kstep; const char* b3 = b2 + kstep;
            if (last && has_next) S.a_ready(nxt);
            if constexpr (SP2) {
            PG8_LDB(B0, 0, 0); PG8_LDB(B1, 0, 1); PG8_SCHED; PG8_LDA(At, 0, 0); PG8_STAGE(PG8_SA(1, 1), a1 + hstep, voffA);
            PG8_WAIT_V(8); PG8_WAIT_L(0); PG8_BAR; PG8_MMA(0, 0, At, B0); PG8_MMA(0, 1, At, B1); PG8_BAR; PG8_SCHED;
            PG8_LDA(At, 0, 1); PG8_STAGE(PG8_SB(0, 0), b2, voffB); PG8_STAGE(PG8_SB(0, 1), b2 + hstep, voffB); PG8_STAGE(PG8_SA(0, 0), a2, voffA);
            PG8_WAIT_V(8); PG8_WAIT_L(0); PG8_BAR; PG8_MMA(1, 0, At, B0); PG8_MMA(1, 1, At, B1); PG8_BAR; PG8_SCHED;
            PG8_LDB(B0, 1, 0); PG8_LDB(B1, 1, 1); PG8_SCHED; PG8_LDA(At, 1, 0); PG8_STAGE(PG8_SA(0, 1), a2 + hstep, voffA);
            PG8_WAIT_V(8); PG8_WAIT_L(0); PG8_BAR; PG8_MMA(0, 0, At, B0); PG8_MMA(0, 1, At, B1); PG8_BAR; PG8_SCHED;
            PG8_LDA(At, 1, 1); PG8_STAGE(PG8_SB(1, 0), b3, voffB); PG8_STAGE(PG8_SB(1, 1), b3 + hstep, voffB); PG8_STAGE(PG8_SA(1, 0), a3, voffA);
            PG8_WAIT_V(8); PG8_WAIT_L(0); PG8_BAR; PG8_MMA(1, 0, At, B0); PG8_MMA(1, 1, At, B1); PG8_BAR; PG8_SCHED;
            } else {
            PG8_LDB(B0, 0, 0); PG8_SCHED; PG8_LDA(At, 0, 0); PG8_STAGE(PG8_SA(1, 1), a1 + hstep, voffA);
            PG8_WAIT_L(8); PG8_BAR; PG8_WAIT_L(0); PG8_MMA(0, 0, At, B0); PG8_BAR; PG8_SCHED;
            PG8_LDB(B1, 0, 1); PG8_STAGE(PG8_SB(0, 0), b2, voffB);
            PG8_BAR; PG8_WAIT_L(0); PG8_MMA(0, 1, At, B1); PG8_BAR;
            PG8_LDA(At, 0, 1); PG8_STAGE(PG8_SA(0, 0), a2, voffA);
            PG8_BAR; PG8_WAIT_L(0); PG8_MMA(1, 0, At, B0); PG8_BAR; PG8_SCHED;
            PG8_STAGE(PG8_SB(0, 1), b2 + hstep, voffB);
            PG8_WAIT_V(6); PG8_BAR; PG8_MMA(1, 1, At, B1); PG8_BAR;
            PG8_LDB(B0, 1, 0); PG8_SCHED; PG8_LDA(At, 1, 0); PG8_STAGE(PG8_SA(0, 1), a2 + hstep, voffA);
            PG8_WAIT_L(8); PG8_BAR; PG8_WAIT_L(0); PG8_MMA(0, 0, At, B0); PG8_BAR; PG8_SCHED;
            PG8_LDB(B1, 1, 1); PG8_STAGE(PG8_SB(1, 0), b3, voffB);
            PG8_BAR; PG8_WAIT_L(0); PG8_MMA(0, 1, At, B1); PG8_BAR;
            PG8_LDA(At, 1, 1); PG8_STAGE(PG8_SA(1, 0), a3, voffA);
            PG8_BAR; PG8_WAIT_L(0); PG8_MMA(1, 0, At, B0); PG8_BAR; PG8_SCHED;
            PG8_STAGE(PG8_SB(1, 1), b3 + hstep, voffB);
            PG8_WAIT_V(6); PG8_BAR; PG8_MMA(1, 1, At, B1); PG8_BAR;
            }
        }
        if constexpr (ALIGN_EPI) { if (wr == 0) PG8_BAR; }
        if constexpr (!Epi::AFTER_DRAIN) { E(acc, cur, wr, wc, fr, fq); S.done(cur); }
        if (!has_next) break;
#pragma unroll
        for (int a = 0; a < 2; ++a)
#pragma unroll
            for (int b = 0; b < 2; ++b)
#pragma unroll
                for (int m = 0; m < 4; ++m)
#pragma unroll
                    for (int n = 0; n < 2; ++n) acc[a][b][m][n] = (f32x4){0.f, 0.f, 0.f, 0.f};
        cur = nxt; cA = nA; cB = nB; ++ui;
        if constexpr (ALIGN_EPI) { if (wr == 1) PG8_BAR; }
    }
    PG8_WAIT_V(0);
    if constexpr (!ALIGN_EPI) { if (wr == 0) PG8_BAR; }
    PG8_BAR;
    if constexpr (Epi::AFTER_DRAIN) { E.fused(acc, cur, wr, wc, fr, fq, lds, wid, lane); S.done(cur); }
#undef PG8_SA
#undef PG8_SB
#undef PG8_STAGE
#undef PG8_LDA
#undef PG8_LDB
#undef PG8_MMA
#undef PG8_WAIT_V
#undef PG8_WAIT_L
#undef PG8_BAR
#undef PG8_SCHED
}
}
#define LAS __attribute__((address_space(3)))
typedef pg8::bf16_t bf16_t;
typedef pg8::bf16x8 bf16x8;
typedef pg8::f32x4 f32x4;
typedef pg8::u32x4 u32x4;
typedef unsigned u32x2 __attribute__((ext_vector_type(2)));
typedef float f32x2 __attribute__((ext_vector_type(2)));

constexpr int D = 1024, NB = 2, SEQ = 16384, DEPTH = 4, CTXL = 256, DFF = 2816;
constexpr int ML = NB * SEQ, MC = NB * CTXL, MT = ML + MC;
constexpr int INW = 2560, C_QA = 0, C_KA = 256, C_VA = 512, C_QB = 768, C_KB = 1024, C_VB = 1280, C_GB = 1792, C_UB = 2304;
constexpr int NTHR = 512, NWAVE = 8;
constexpr int LDS_BYTES = 147456;
constexpr size_t MiB = 1u << 20;
constexpr size_t WS_DIAG = 0, WS_MODV = 1 * MiB, WS_ROPE = 2 * MiB, WS_S5T = 3 * MiB, WS_XC = 6 * MiB, WS_H = 8 * MiB, WS_Y = 73 * MiB, WS_HID = 138 * MiB,
                 WS_WB = 317 * MiB, WS_KV = 358 * MiB, WS_S5Y = 423 * MiB, WS_S5E = 456 * MiB, WS_G = 465 * MiB, WS_WB2 = 482 * MiB, WS_SB16 = 523 * MiB, WS_END = 556 * MiB;
constexpr size_t S5T_LAYER = 512 * 1024, S5T_ABL = 16384, S5T_BB = 32768, S5T_CC = 163840;
constexpr size_t WB_F1IN = 0, WB_F1OUT = 11 * MiB, WB_WIN = WB_F1OUT + 5767168, WB_WOUT = WB_WIN + 5 * MiB, WB_F2IN = WB_WOUT + 2 * MiB, WB_F2OUT = WB_F2IN + 11 * MiB, WB_GLU = WB_F2OUT + 5767168;
static_assert(WB_GLU + 262144 <= 41 * MiB, "weights map");

struct Params { const float* in[26]; float* out; unsigned char* ws; };
struct Ctx { int tid, bid, nb; };

__device__ __forceinline__ unsigned pk2(float lo, float hi) { unsigned r; asm("v_cvt_pk_bf16_f32 %0, %1, %2" : "=v"(r) : "v"(lo), "v"(hi)); return r; }
__device__ __forceinline__ unsigned f2bf(float f) { return pk2(f, f) & 0xffffu; }
__device__ __forceinline__ float bflo(unsigned u) { return __builtin_bit_cast(float, u << 16); }
__device__ __forceinline__ float bfhi(unsigned u) { return __builtin_bit_cast(float, u & 0xffff0000u); }
__device__ __forceinline__ float bf1(bf16_t h) { return __builtin_bit_cast(float, (unsigned)h << 16); }
__device__ __forceinline__ void unpack8(const u32x4 v, float* o) { o[0] = bflo(v.x); o[1] = bfhi(v.x); o[2] = bflo(v.y); o[3] = bfhi(v.y); o[4] = bflo(v.z); o[5] = bfhi(v.z); o[6] = bflo(v.w); o[7] = bfhi(v.w); }
__device__ __forceinline__ u32x4 pack8(const float* o) { u32x4 w; w.x = pk2(o[0], o[1]); w.y = pk2(o[2], o[3]); w.z = pk2(o[4], o[5]); w.w = pk2(o[6], o[7]); return w; }
__device__ __forceinline__ float wave_sum(float v) {
#pragma unroll
    for (int o = 1; o < 64; o <<= 1) v += __shfl_xor(v, o);
    return v;
}
__device__ __forceinline__ float rows_sum(float v) {
    unsigned u = __builtin_bit_cast(unsigned, v);
    auto a = __builtin_amdgcn_permlane16_swap(u, u, false, false);
    const float s = __builtin_bit_cast(float, (unsigned)a[0]) + __builtin_bit_cast(float, (unsigned)a[1]);
    u = __builtin_bit_cast(unsigned, s);
    auto b = __builtin_amdgcn_permlane32_swap(u, u, false, false);
    return __builtin_bit_cast(float, (unsigned)b[0]) + __builtin_bit_cast(float, (unsigned)b[1]);
}
__device__ __forceinline__ float rows_max(float v) {
    unsigned u = __builtin_bit_cast(unsigned, v);
    auto a = __builtin_amdgcn_permlane16_swap(u, u, false, false);
    const float s = fmaxf(__builtin_bit_cast(float, (unsigned)a[0]), __builtin_bit_cast(float, (unsigned)a[1]));
    u = __builtin_bit_cast(unsigned, s);
    auto b = __builtin_amdgcn_permlane32_swap(u, u, false, false);
    return fmaxf(__builtin_bit_cast(float, (unsigned)b[0]), __builtin_bit_cast(float, (unsigned)b[1]));
}
__device__ __forceinline__ float log_sigmoid(float x) { return -log1pf(expf(-x)); }
#define MFMA16(a, b, c) __builtin_amdgcn_mfma_f32_16x16x32_bf16((a), (b), (c), 0, 0, 0)
typedef short v4i16_t __attribute__((ext_vector_type(4)));
__device__ __forceinline__ u32x2 tr4(const LAS unsigned char* p) { return __builtin_bit_cast(u32x2, __builtin_amdgcn_ds_read_tr16_b64_v4i16((LAS v4i16_t*)p)); }
__device__ __forceinline__ bf16x8 tr8(const LAS unsigned char* base, int stride, int r0, int c0, int fr) {
    const LAS unsigned char* p = base + (r0 + (fr >> 2)) * stride + (c0 + 4 * (fr & 3)) * 2;
    const u32x2 lo = tr4(p), hi = tr4(p + 4 * stride);
    return __builtin_bit_cast(bf16x8, ((u32x4){lo.x, lo.y, hi.x, hi.y}));
}
__device__ __forceinline__ bf16x8 tr8ab(const LAS unsigned char* base, int stride, int rA, int rB, int c0, int fr) {
    const int ro = fr >> 2, co = (c0 + 4 * (fr & 3)) * 2;
    const u32x2 lo = tr4(base + (rA + ro) * stride + co), hi = tr4(base + (rB + ro) * stride + co);
    return __builtin_bit_cast(bf16x8, ((u32x4){lo.x, lo.y, hi.x, hi.y}));
}

__device__ __forceinline__ void phase_modv(const Ctx cx, const Params& p, LAS unsigned char* lds) {
    LAS float* sv = (LAS float*)lds;
    LAS float* red = (LAS float*)(lds + 12288);
    const int tid = cx.tid;
    for (int i = tid; i < 3072; i += NTHR) { const int which = i >> 10, k = i & 1023; const float c = which < 2 ? p.in[1][which * 1024 + k] : p.in[3][k]; sv[i] = c / (1.f + expf(-c)); }
    __syncthreads();
    float* modv = (float*)(p.ws + WS_MODV);
    const int kg = tid >> 4, cq = tid & 15;
    for (int item = cx.bid; item < 576; item += cx.nb) {
        const int l = item / 144, n0 = (item % 144) * 64;
        const float* W = p.in[4] + (size_t)l * 1024 * 9216 + n0 + 4 * cq;
        f32x4 a0 = {0.f, 0.f, 0.f, 0.f}, a1 = a0, a2 = a0;
#pragma unroll 8
        for (int kk = 0; kk < 32; ++kk) { const int k = kg * 32 + kk; const f32x4 w = *(const f32x4*)(W + (size_t)k * 9216); a0 += sv[k] * w; a1 += sv[1024 + k] * w; a2 += sv[2048 + k] * w; }
        ((LAS f32x4*)(red + (kg * 3 + 0) * 64))[cq] = a0; ((LAS f32x4*)(red + (kg * 3 + 1) * 64))[cq] = a1; ((LAS f32x4*)(red + (kg * 3 + 2) * 64))[cq] = a2;
        __syncthreads();
        if (tid < 192) { const int i = tid >> 6, c = tid & 63; float s = 0.f;
            for (int g = 0; g < 32; ++g) s += red[(g * 3 + i) * 64 + c];
            modv[(size_t)(l * 3 + i) * 9216 + n0 + c] = s + p.in[5][l * 9216 + n0 + c]; }
        __syncthreads();
    }
}
__device__ __forceinline__ void sincos_cw(float x, float& sn, float& cs) {
    const float n = rintf(x * 0.6366197723675814f);
    float r = fmaf(-n, 1.5703125f, x); r = fmaf(-n, 4.837512969970703125e-4f, r); r = fmaf(-n, 7.54978995489188216e-8f, r);
    const float z = r * r;
    const float s = r + r * z * (-1.6666654611e-1f + z * (8.3321608736e-3f + z * (-1.9515295891e-4f)));
    const float c = 1.f - 0.5f * z + z * z * (4.166664568298827e-2f + z * (-1.388731625493765e-3f + z * 2.443315711809948e-5f));
    const int q = ((int)n) & 3;
    sn = (q == 0) ? s : (q == 1) ? c : (q == 2) ? -s : -c;
    cs = (q == 0) ? c : (q == 1) ? -s : (q == 2) ? -c : s;
}
__device__ __forceinline__ void phase_tables(const Ctx cx, const Params& p) {
    const int gt = cx.bid * NTHR + cx.tid, nth = cx.nb * NTHR;
    float* rope = (float*)(p.ws + WS_ROPE);
    for (int i = gt; i < 5120; i += nth) { const bool isrow = i < 4096; const int j = isrow ? i : i - 4096; const int pos = j >> 4, f = j & 15;
        const float inv = exp2f(-(float)f * (13.287712379549449f / 16.f)); const float ang = (float)pos * inv; float c, s; sincos_cw(ang, s, c);
        if (isrow) { rope[j] = c; rope[4096 + j] = s; } else { rope[8192 + j] = c; rope[9216 + j] = s; } }
    for (int i = gt; i < 8192; i += nth) {
        const int l = i >> 11, r = i & 2047, dir = r >> 10, g = (r >> 6) & 15, pp = r & 63;
        const float a_re = fminf(p.in[15][i], -1e-4f), a_im = p.in[16][i]; const float dt = expf(p.in[17][(l * 2 + dir) * 16 + g]);
        const float mag = expf(dt * a_re); float sn_, cs_; sincos_cw(dt * a_im, sn_, cs_); const float abr = mag * cs_, abi = mag * sn_;
        float pr = abr, pi = abi;
#pragma unroll
        for (int q = 0; q < 6; ++q) { const float nr2 = pr * pr - pi * pi, ni2 = 2.f * pr * pi; pr = nr2; pi = ni2; }
        const float den = a_re * a_re + a_im * a_im, nr = abr - 1.f; const float f_re = (nr * a_re + abi * a_im) / den, f_im = (abi * a_re - nr * a_im) / den;
        unsigned char* base = p.ws + WS_S5T + (size_t)l * S5T_LAYER;
        ((f32x2*)base)[r] = (f32x2){abr, abi}; ((f32x2*)(base + S5T_ABL))[r] = (f32x2){pr, pi};
        const float* br = p.in[18] + ((size_t)(l * 16 + g) * 64 + pp) * 16; const float* bi = p.in[19] + ((size_t)(l * 16 + g) * 64 + pp) * 16;
        f32x4 brv[4], biv[4];
#pragma unroll
        for (int c = 0; c < 4; ++c) { brv[c] = ((const f32x4*)br)[c]; biv[c] = ((const f32x4*)bi)[c]; }
        float cre[16], cim[16];
#pragma unroll
        for (int co = 0; co < 16; ++co) { const size_t ci = ((size_t)((l * 2 + dir) * 16 + g) * 16 + co) * 64 + pp; cre[co] = p.in[20][ci]; cim[co] = p.in[21][ci]; }
        asm volatile("" ::: "memory");
        float bre[16], bim[16];
#pragma unroll
        for (int c = 0; c < 4; ++c)
#pragma unroll
            for (int e = 0; e < 4; ++e) { bre[4 * c + e] = f_re * brv[c][e] - f_im * biv[c][e]; bim[4 * c + e] = f_re * biv[c][e] + f_im * brv[c][e]; }
        const int dg = r >> 6;
        u32x4* rowre = (u32x4*)(base + S5T_BB + ((size_t)dg * 128 + 2 * pp) * 32); u32x4* rowim = (u32x4*)(base + S5T_BB + ((size_t)dg * 128 + 2 * pp + 1) * 32);
        rowre[0] = pack8(bre); rowre[1] = pack8(bre + 8); rowim[0] = pack8(bim); rowim[1] = pack8(bim + 8);
        bf16_t* cc = (bf16_t*)(base + S5T_CC) + (size_t)dg * 16 * 128;
#pragma unroll
        for (int co = 0; co < 16; ++co) ((unsigned*)(cc + co * 128))[pp] = pk2(cre[co], -cim[co]);
    }
}
__device__ __forceinline__ void transpose_item(const float* W, int K, int N, bf16_t* WT, int mode, LAS float* scr, int item, int lane) {
    const int nblk = N / 32, kb = item / nblk, nb = item % nblk, k0 = 64 * kb, n0 = 32 * nb;
    int d0 = n0; if (mode) { const int half = N >> 1; const int nn = n0 < half ? n0 : n0 - half; d0 = (nn >> 7) * 256 + (nn & 127) + (n0 < half ? 0 : 128); }
#pragma unroll 8
    for (int i = 0; i < 32; ++i) { const int kk = 2 * i + (lane >> 5); scr[kk * 33 + (lane & 31)] = W[(size_t)(k0 + kk) * N + n0 + (lane & 31)]; }
    asm volatile("s_waitcnt lgkmcnt(0)" ::: "memory");
    const int c = lane & 7;
#pragma unroll
    for (int j = 0; j < 4; ++j) { const int n = (lane >> 3) + 8 * j; const LAS float* s = scr + (8 * c) * 33 + n;
        u32x4 o; o.x = pk2(s[0 * 33], s[1 * 33]); o.y = pk2(s[2 * 33], s[3 * 33]); o.z = pk2(s[4 * 33], s[5 * 33]); o.w = pk2(s[6 * 33], s[7 * 33]);
        *(u32x4*)(WT + (size_t)(d0 + n) * K + k0 + 8 * c) = o; }
    asm volatile("s_waitcnt lgkmcnt(0)" ::: "memory");
}
__device__ __forceinline__ void phase_conv(const Ctx cx, const Params& p, int l, LAS unsigned char* lds) {
    const int wave = cx.tid >> 6, lane = cx.tid & 63;
    LAS float* scr = (LAS float*)(lds + wave * 16384);
    const int gw = cx.bid * NWAVE + wave, NGW = cx.nb * NWAVE;
    constexpr int I1 = 16 * 176, I2 = 44 * 32, I3 = 16 * 80, I4 = 16 * 32, I7 = 4 * 16;
    constexpr int TOT = 2 * I1 + 2 * I2 + I3 + I4 + I7;
    unsigned char* wb = p.ws + ((l & 1) ? WS_WB2 : WS_WB);
    for (int it = gw; it < TOT; it += NGW) {
        int r = it;
        if (r < I1) { transpose_item(p.in[6] + (size_t)l * 1024 * 5632, 1024, 5632, (bf16_t*)(wb + WB_F1IN), 1, scr, r, lane); continue; } r -= I1;
        if (r < I2) { transpose_item(p.in[7] + (size_t)l * 2816 * 1024, 2816, 1024, (bf16_t*)(wb + WB_F1OUT), 0, scr, r, lane); continue; } r -= I2;
        if (r < I3) { transpose_item(p.in[8] + (size_t)l * 1024 * 2560, 1024, 2560, (bf16_t*)(wb + WB_WIN), 0, scr, r, lane); continue; } r -= I3;
        if (r < I4) { transpose_item(p.in[9] + (size_t)l * 1024 * 1024, 1024, 1024, (bf16_t*)(wb + WB_WOUT), 0, scr, r, lane); continue; } r -= I4;
        if (r < I1) { transpose_item(p.in[24] + (size_t)l * 1024 * 5632, 1024, 5632, (bf16_t*)(wb + WB_F2IN), 1, scr, r, lane); continue; } r -= I1;
        if (r < I2) { transpose_item(p.in[25] + (size_t)l * 2816 * 1024, 2816, 1024, (bf16_t*)(wb + WB_F2OUT), 0, scr, r, lane); continue; } r -= I2;
        transpose_item(p.in[23] + (size_t)l * 256 * 512, 256, 512, (bf16_t*)(wb + WB_GLU), 1, scr, r, lane);
    }
}
__device__ __forceinline__ void phase_norm(const Ctx cx, const float* xl, float* xc, const float* modl, int ish, int isc, bf16_t* H, const float* part, int pend_nch, int m_end) {
    const int wave = cx.tid >> 6, lane = cx.tid & 63;
    const int gw = cx.bid * NWAVE + wave, NGW = cx.nb * NWAVE;
    for (int m = gw; m < m_end; m += NGW) {
        const float* xr = m < ML ? xl + (size_t)m * D : xc + (size_t)(m - ML) * D; const int mi = m < ML ? (m >> 14) : 2;
        const f32x4* sh = (const f32x4*)(modl + mi * 9216 + ish * 1024); const f32x4* sc = (const f32x4*)(modl + mi * 9216 + isc * 1024);
        f32x4 v[4], scv[4], shv[4]; float s = 0.f;
#pragma unroll
        for (int j = 0; j < 4; ++j) { v[j] = ((const f32x4*)xr)[lane + 64 * j]; scv[j] = sc[lane + 64 * j]; shv[j] = sh[lane + 64 * j]; }
        if (m >= ML && pend_nch > 0) {
            for (int ch = 0; ch < pend_nch; ++ch) { const f32x4* pr = (const f32x4*)(part + ((size_t)ch * 512 + (m - ML)) * 1024);
#pragma unroll
                for (int j = 0; j < 4; ++j) v[j] += pr[lane + 64 * j]; }
#pragma unroll
            for (int j = 0; j < 4; ++j) ((f32x4*)(xc + (size_t)(m - ML) * D))[lane + 64 * j] = v[j];
        }
#pragma unroll
        for (int j = 0; j < 4; ++j) s += (v[j].x * v[j].x + v[j].y * v[j].y) + (v[j].z * v[j].z + v[j].w * v[j].w);
        const float r = 1.f / sqrtf(wave_sum(s) * (1.f / D) + 1e-6f);
        u32x2* o8 = (u32x2*)(H + (size_t)m * D);
#pragma unroll
        for (int j = 0; j < 4; ++j) { const f32x4 a = scv[j], b = shv[j]; const f32x4 o = v[j] * r * (a + 1.f) + b;
            o8[lane + 64 * j] = (u32x2){pk2(o.x, o.y), pk2(o.z, o.w)}; }
    }
}
constexpr int NM_KL = 0, NM_KC = 56320, NM_VL = 76800, NM_VC = 121856, NM_BIAS = 138240, NA_LAT_ITEMS = 1024, NA_ITEMS = NA_LAT_ITEMS + 16;
__device__ __forceinline__ void na_item(const Ctx cx, const Params& p, int l, int item, LAS unsigned char* lds, const int stage_only = 0) {
    const int tid = cx.tid, wave = tid >> 6, lane = tid & 63, fr = lane & 15, fq = lane >> 4;
    const bf16_t* proj = (const bf16_t*)(p.ws + WS_HID);
    bf16_t* Y = (bf16_t*)(p.ws + WS_Y);
    const bool lat = item < NA_LAT_ITEMS;
    int b, h, rq = 0;
    if (lat) { b = item >> 9; h = (item >> 6) & 7; rq = item & 63; } else { const int j = item - NA_LAT_ITEMS; b = j >> 3; h = j & 7; }
    const int r0 = 4 * rq; const int rs0 = min(max(r0 - 4, 0), 248), rsl = min(max(r0 - 1, 0), 248);
    const int nkl = lat ? (rsl + 8 - rs0) * 64 : 0;
    const float* kgain = p.in[11] + l * 32; const float* qgain = p.in[10] + l * 32;
    { u32x4 kreg[2][4], vreg[2][4];
#pragma unroll
      for (int rr = 0; rr < 2; ++rr) { const int i = tid + NTHR * rr;
          if (i < nkl + 256) { const size_t row = i < nkl ? (size_t)b * SEQ + rs0 * 64 + i : (size_t)ML + b * CTXL + (i - nkl);
              const u32x4* ks = (const u32x4*)(proj + row * INW + C_KA + h * 32); const u32x4* vs = (const u32x4*)(proj + row * INW + C_VA + h * 32);
#pragma unroll
              for (int c = 0; c < 4; ++c) { kreg[rr][c] = ks[c]; vreg[rr][c] = vs[c]; } } }
      if (tid < 465) ((LAS float*)(lds + NM_BIAS))[tid] = 1.4426950408889634f * p.in[12][(size_t)(l * 8 + h) * 465 + tid];
#pragma unroll
      for (int rr = 0; rr < 2; ++rr) { const int i = tid + NTHR * rr;
          if (i < nkl + 256) {
              LAS unsigned char *dk, *dv;
              if (i < nkl) { dk = lds + NM_KL + i * 80; dv = lds + NM_VL + i * 64; }
              else { const int c = i - nkl; dk = lds + NM_KC + c * 80; dv = lds + NM_VC + c * 64; }
              float kf[32]; float ss = 0.f;
#pragma unroll
              for (int c = 0; c < 4; ++c) { unpack8(kreg[rr][c], kf + 8 * c); }
#pragma unroll
              for (int d = 0; d < 32; ++d) ss += kf[d] * kf[d];
              const float rn = 1.f / sqrtf(ss * (1.f / 32.f) + 1e-6f);
#pragma unroll
              for (int d = 0; d < 32; ++d) kf[d] = kf[d] * rn * kgain[d];
#pragma unroll
              for (int c = 0; c < 4; ++c) { *(LAS u32x4*)(dk + 16 * c) = pack8(kf + 8 * c); *(LAS u32x4*)(dv + 16 * c) = vreg[rr][c]; } } } }
    __syncthreads();
    const LAS float* bias = (const LAS float*)(lds + NM_BIAS);
    if (!stage_only) {
        int r_[2], wq_[2], rs_[2], cs_[2], c0_[2]; size_t qrow_[2]; bf16x8 qf_[2]; int co_[2][2][4]; float okm_[2][2][4];
        float mrun[2], lsum[2]; f32x4 o0[2], o1[2];
#pragma unroll
        for (int t = 0; t < 2; ++t) { const int qt = wave + 8 * t;
            const int r = r0 + (qt >> 2), w0 = 16 * (qt & 3), wq = w0 + fr;
            const size_t qrow = lat ? (size_t)b * SEQ + r * 64 + wq : (size_t)ML + b * CTXL + qt * 16 + fr;
            float q[8]; unpack8(*(const u32x4*)(proj + qrow * INW + C_QA + h * 32 + 8 * fq), q); float ss = 0.f;
#pragma unroll
            for (int e = 0; e < 8; ++e) ss += q[e] * q[e];
            ss = rows_sum(ss);
            const float rn = (0.17677669529663687f * 1.4426950408889634f) / sqrtf(ss * (1.f / 32.f) + 1e-6f);
#pragma unroll
            for (int e = 0; e < 8; ++e) q[e] = q[e] * rn * qgain[8 * fq + e];
            qf_[t] = __builtin_bit_cast(bf16x8, pack8(q));
            r_[t] = r; wq_[t] = wq; qrow_[t] = qrow; rs_[t] = min(max(r - 4, 0), 248); cs_[t] = min(max(wq - 8, 0), 48); c0_[t] = min(max(w0 - 8, 0), 32);
            mrun[t] = -1e30f; lsum[t] = 0.f; o0[t] = (f32x4){0.f, 0.f, 0.f, 0.f}; o1[t] = o0[t];
#pragma unroll
            for (int cbi = 0; cbi < 2; ++cbi)
#pragma unroll
                for (int e = 0; e < 4; ++e) { const int kc = c0_[t] + 16 * cbi + 4 * fq + e; co_[t][cbi][e] = min(max(kc - wq + 15, 0), 30); okm_[t][cbi][e] = ((kc >= cs_[t]) && (kc < cs_[t] + 16)) ? 0.f : -1e30f; } }
        const int ngrp = lat ? 8 : 4;
#pragma unroll 1
        for (int g = 0; g < ngrp; ++g) {
            f32x4 s[2][4]; int vk[2][4];
            const LAS unsigned char* vb;
            if (g < 4) { vb = lds + NM_VC;
#pragma unroll
                for (int i = 0; i < 4; ++i) { const int kt = 4 * g + i;
                    const bf16x8 a = *(const LAS bf16x8*)(lds + NM_KC + (16 * kt + fr) * 80 + 16 * fq);
#pragma unroll
                    for (int t = 0; t < 2; ++t) { vk[t][i] = 16 * kt; s[t][i] = MFMA16(a, qf_[t], ((f32x4){0.f, 0.f, 0.f, 0.f})); } }
            } else { vb = lds + NM_VL;
#pragma unroll
                for (int t = 0; t < 2; ++t)
#pragma unroll
                    for (int i = 0; i < 4; ++i) { const int lt = 4 * (g - 4) + i; const int kri = lt >> 1, cb = c0_[t] + 16 * (lt & 1); const int kr = rs_[t] + kri; const int base = (kr - rs0) * 64 + cb; vk[t][i] = base;
                        const bf16x8 a = *(const LAS bf16x8*)(lds + NM_KL + (base + fr) * 80 + 16 * fq); f32x4 sv = MFMA16(a, qf_[t], ((f32x4){0.f, 0.f, 0.f, 0.f}));
                        const LAS float* brow = bias + (kr - r_[t] + 7) * 31;
                        float bv[4];
#pragma unroll
                        for (int e = 0; e < 4; ++e) bv[e] = brow[co_[t][lt & 1][e]];
#pragma unroll
                        for (int e = 0; e < 4; ++e) asm volatile("" : "+v"(bv[e]));
#pragma unroll
                        for (int e = 0; e < 4; ++e) sv[e] = (okm_[t][lt & 1][e] < 0.f) ? -1e30f : sv[e] + bv[e];
                        s[t][i] = sv; }
            }
            float gm[2];
#pragma unroll
            for (int t = 0; t < 2; ++t) { float m_ = -1e30f;
#pragma unroll
                for (int i = 0; i < 4; ++i) m_ = fmaxf(m_, fmaxf(fmaxf(s[t][i][0], s[t][i][1]), fmaxf(s[t][i][2], s[t][i][3])));
                gm[t] = m_; }
#pragma unroll
            for (int t = 0; t < 2; ++t) gm[t] = rows_max(gm[t]);
            float pe[2][16];
#pragma unroll
            for (int t = 0; t < 2; ++t) { const float mn = fmaxf(mrun[t], gm[t]); const float alpha = __builtin_amdgcn_exp2f(mrun[t] - mn); mrun[t] = mn; lsum[t] *= alpha; o0[t] = o0[t] * alpha; o1[t] = o1[t] * alpha;
#pragma unroll
                for (int i = 0; i < 4; ++i)
#pragma unroll
                    for (int e = 0; e < 4; ++e) { const float pv = __builtin_amdgcn_exp2f(s[t][i][e] - mn); pe[t][4 * i + e] = pv; lsum[t] += pv; } }
#pragma unroll
            for (int pr = 0; pr < 2; ++pr)
#pragma unroll
                for (int t = 0; t < 2; ++t) {
                    const bf16x8 pb = __builtin_bit_cast(bf16x8, pack8(pe[t] + 8 * pr));
                    const int kA = vk[t][2 * pr] + 4 * fq, kB = vk[t][2 * pr + 1] + 4 * fq;
                    o0[t] = MFMA16(tr8ab(vb, 64, kA, kB, 0, fr), pb, o0[t]); o1[t] = MFMA16(tr8ab(vb, 64, kA, kB, 16, fr), pb, o1[t]);
                }
        }
#pragma unroll
        for (int t = 0; t < 2; ++t) {
            const float ls = rows_sum(lsum[t]);
            const float inv = 1.f / ls;
            *(u32x2*)(Y + qrow_[t] * D + h * 32 + 4 * fq) = (u32x2){pk2(o0[t][0] * inv, o0[t][1] * inv), pk2(o0[t][2] * inv, o0[t][3] * inv)};
            *(u32x2*)(Y + qrow_[t] * D + h * 32 + 16 + 4 * fq) = (u32x2){pk2(o1[t][0] * inv, o1[t][1] * inv), pk2(o1[t][2] * inv, o1[t][3] * inv)};
        }
    }
    __syncthreads();
}
__device__ __forceinline__ size_t ret_row(int b, int sc, int j) { return sc < 2 ? (size_t)ML + b * CTXL + sc * 128 + j : (size_t)b * SEQ + (sc - 2) * 128 + j; }
__device__ __forceinline__ void rope16(const bf16_t* src, int q, bool lat, int trow, int tcol, const float* rope, float* o1, float* o2) {
    float z1[8], z2[8]; unpack8(*(const u32x4*)(src + 8 * q), z1); unpack8(*(const u32x4*)(src + 32 + 8 * q), z2);
    if (lat) {
        const float* cp = q < 2 ? rope + trow * 16 + 8 * q : rope + 8192 + tcol * 16 + 8 * (q - 2);
        const float* sp = q < 2 ? rope + 4096 + trow * 16 + 8 * q : rope + 9216 + tcol * 16 + 8 * (q - 2);
#pragma unroll
        for (int e = 0; e < 8; ++e) { const float c = cp[e], s = sp[e]; o1[e] = z1[e] * c - z2[e] * s; o2[e] = z1[e] * s + z2[e] * c; }
    } else {
#pragma unroll
        for (int e = 0; e < 8; ++e) { o1[e] = z1[e]; o2[e] = z2[e]; }
    }
}
__device__ __forceinline__ void rope_tab_load(const float* rope, int q, int trow, int tcol, f32x4* tab) {
    const float* cp = q < 2 ? rope + trow * 16 + 8 * q : rope + 8192 + tcol * 16 + 8 * (q - 2);
    const float* sp = q < 2 ? rope + 4096 + trow * 16 + 8 * q : rope + 9216 + tcol * 16 + 8 * (q - 2);
    tab[0] = ((const f32x4*)cp)[0]; tab[1] = ((const f32x4*)cp)[1]; tab[2] = ((const f32x4*)sp)[0]; tab[3] = ((const f32x4*)sp)[1];
}
__device__ __forceinline__ void rope_apply(const u32x4 lo, const u32x4 hi, bool lat, const f32x4* tab, float* o1, float* o2) {
    float z1[8], z2[8]; unpack8(lo, z1); unpack8(hi, z2);
    if (lat) {
#pragma unroll
        for (int e = 0; e < 8; ++e) { const float c = tab[e >> 2][e & 3], sn = tab[2 + (e >> 2)][e & 3]; o1[e] = z1[e] * c - z2[e] * sn; o2[e] = z1[e] * sn + z2[e] * c; }
    } else {
#pragma unroll
        for (int e = 0; e < 8; ++e) { o1[e] = z1[e]; o2[e] = z2[e]; }
    }
}
__device__ __forceinline__ void stage_v(const bf16_t* proj, int b, int h, int sc, LAS unsigned char* vrow, int tid) {
    const int j = tid >> 2, q = tid & 3;
    const u32x4* vs = (const u32x4*)(proj + ret_row(b, sc, j) * INW + C_VB + h * 128 + 32 * q);
#pragma unroll
    for (int c = 0; c < 4; ++c) *(LAS u32x4*)(vrow + j * 288 + 64 * q + 16 * c) = vs[c];
}
constexpr int R1_V = 0, R1_KF = 36864, R1_KB = 57344, RET_ITEMS = NB * 4 * 130;
__device__ __forceinline__ void ret_kv_item(const Ctx cx, const Params& p, int l, int item, LAS unsigned char* lds) {
    const int tid = cx.tid, wave = tid >> 6, lane = tid & 63, fr = lane & 15, fq = lane >> 4;
    const bf16_t* proj = (const bf16_t*)(p.ws + WS_HID); const float* rope = (const float*)(p.ws + WS_ROPE);
    const int b = item / 520, h = (item / 130) & 3, sc = item % 130; const bool lat = sc >= 2;
    const float lgf = log_sigmoid(p.in[13][(l * 2 + 0) * 4 + h]), lgb = log_sigmoid(p.in[13][(l * 2 + 1) * 4 + h]);
    {
      const int j = tid >> 2, q = tid & 3; const int t = (sc - 2) * 128 + j; const size_t row = ret_row(b, sc, j);
      const bf16_t* ksrc = proj + row * INW + C_KB + h * 64;
      const u32x4 k0 = *(const u32x4*)(ksrc + 8 * q), k1 = *(const u32x4*)(ksrc + 32 + 8 * q);
      const u32x4* vs = (const u32x4*)(proj + row * INW + C_VB + h * 128 + 32 * q);
      u32x4 vv[4];
#pragma unroll
      for (int c = 0; c < 4; ++c) vv[c] = vs[c];
      f32x4 tab[4];
      if (lat) rope_tab_load(rope, q, t >> 6, t & 63, tab);
      float o1[8], o2[8]; rope_apply(k0, k1, lat, tab, o1, o2);
      const float wf = 0.125f * __builtin_amdgcn_exp2f(1.4426950408889634f * lgf * (float)(127 - j)), wb = 0.125f * __builtin_amdgcn_exp2f(1.4426950408889634f * lgb * (float)j);
      float t1[8], t2[8];
#pragma unroll
      for (int e = 0; e < 8; ++e) { t1[e] = o1[e] * wf; t2[e] = o2[e] * wf; }
      *(LAS u32x4*)(lds + R1_KF + j * 160 + 16 * q) = pack8(t1); *(LAS u32x4*)(lds + R1_KF + j * 160 + 64 + 16 * q) = pack8(t2);
#pragma unroll
      for (int e = 0; e < 8; ++e) { t1[e] = o1[e] * wb; t2[e] = o2[e] * wb; }
      *(LAS u32x4*)(lds + R1_KB + j * 160 + 16 * q) = pack8(t1); *(LAS u32x4*)(lds + R1_KB + j * 160 + 64 + 16 * q) = pack8(t2);
#pragma unroll
      for (int c = 0; c < 4; ++c) *(LAS u32x4*)(lds + R1_V + j * 288 + 64 * q + 16 * c) = vv[c]; }
    __syncthreads();
    bf16x8 a[4];
#pragma unroll
    for (int ks = 0; ks < 4; ++ks) a[ks] = tr8(lds + R1_V, 288, 32 * ks + 8 * fq, 16 * wave, fr);
    float* kvf = (float*)(p.ws + WS_KV) + ((size_t)((b * 4 + h) * 2 + 0) * 130 + sc) * 8192;
    float* kvb = (float*)(p.ws + WS_KV) + ((size_t)((b * 4 + h) * 2 + 1) * 130 + sc) * 8192;
#pragma unroll
    for (int nt = 0; nt < 4; ++nt) { f32x4 cf = {0.f, 0.f, 0.f, 0.f}, cb = cf;
#pragma unroll
        for (int ks = 0; ks < 4; ++ks) { const bf16x8 bf = tr8(lds + R1_KF, 160, 32 * ks + 8 * fq, 16 * nt, fr); const bf16x8 bb = tr8(lds + R1_KB, 160, 32 * ks + 8 * fq, 16 * nt, fr);
            cf = MFMA16(bf, a[ks], cf); cb = MFMA16(bb, a[ks], cb); }
        *(f32x4*)(kvf + (16 * wave + fr) * 64 + 16 * nt + 4 * fq) = cf; *(f32x4*)(kvb + (16 * wave + fr) * 64 + 16 * nt + 4 * fq) = cb; }
    __syncthreads();
}
__device__ __forceinline__ void phase_scans(const Ctx cx, const Params& p, int l) {
    const int tid = cx.tid;
    for (int gt = cx.bid * NTHR + tid; gt < 16 * 8192; gt += cx.nb * NTHR) {
        const int idx = gt & 8191, seq = gt >> 13, dir = seq & 1, h = (seq >> 1) & 3;
        const float gch = expf(128.f * log_sigmoid(p.in[13][(l * 2 + dir) * 4 + h]));
        const float* base = (const float*)(p.ws + WS_KV) + (size_t)seq * 130 * 8192 + idx;
        bf16_t* sb16 = (bf16_t*)(p.ws + WS_SB16) + (size_t)seq * 130 * 8192 + idx;
        float S = 0.f;
        for (int k0 = 0; k0 < 130; k0 += 26) { float t[26];
#pragma unroll
            for (int k = 0; k < 26; ++k) { const int kk = k0 + k; const int sc = dir == 0 ? kk : (kk < 2 ? 1 - kk : 131 - kk); t[k] = base[(size_t)sc * 8192]; }
            asm volatile("" ::: "memory");
#pragma unroll
            for (int k = 0; k < 26; ++k) { const int kk = k0 + k; const int sc = dir == 0 ? kk : (kk < 2 ? 1 - kk : 131 - kk); sb16[(size_t)sc * 8192] = (bf16_t)f2bf(S); S = gch * S + t[k]; } }
    }
    if (tid < 64) for (int w = cx.bid; w < 64; w += cx.nb) {
        const int e = w * 64 + tid; const int pp = e & 63, seq = e >> 6, dir = seq & 1, g = (seq >> 1) & 15;
        const f32x2 al = ((const f32x2*)(p.ws + WS_S5T + (size_t)l * S5T_LAYER + S5T_ABL))[(dir * 16 + g) * 64 + pp];
        f32x2* base = (f32x2*)(p.ws + WS_S5E) + (size_t)seq * 260 * 64 + pp;
        float xr = 0.f, xi = 0.f;
        for (int k0 = 0; k0 < 260; k0 += 26) { f32x2 t[26];
#pragma unroll
            for (int k = 0; k < 26; ++k) { const int kk = k0 + k; const int sc = dir == 0 ? kk : (kk < 4 ? 3 - kk : 263 - kk); t[k] = base[(size_t)sc * 64]; }
            asm volatile("" ::: "memory");
#pragma unroll
            for (int k = 0; k < 26; ++k) { const int kk = k0 + k; const int sc = dir == 0 ? kk : (kk < 4 ? 3 - kk : 263 - kk); base[(size_t)sc * 64] = (f32x2){xr, xi};
                const float nr = al.x * xr - al.y * xi + t[k].x, ni = al.x * xi + al.y * xr + t[k].y; xr = nr; xi = ni; } }
    }
}
constexpr int R2_Q = 0, R2_K = 18432, R2_V = 36864, R2_P = 73728, R2_SF = 108544, R2_SB = 126976;
__device__ __forceinline__ void ret_out_item(const Ctx cx, const Params& p, int l, int item, LAS unsigned char* lds) {
    const int tid = cx.tid, wave = tid >> 6, lane = tid & 63, fr = lane & 15, fq = lane >> 4;
    const bf16_t* proj = (const bf16_t*)(p.ws + WS_HID); const float* rope = (const float*)(p.ws + WS_ROPE); bf16_t* Y = (bf16_t*)(p.ws + WS_Y);
    const int b = item / 520, h = (item / 130) & 3, sc = item % 130; const bool lat = sc >= 2;
    const float l2f = 1.4426950408889634f * log_sigmoid(p.in[13][(l * 2 + 0) * 4 + h]), l2b = 1.4426950408889634f * log_sigmoid(p.in[13][(l * 2 + 1) * 4 + h]);
    {
      const int j = tid >> 2, q = tid & 3; const int t = (sc - 2) * 128 + j; const size_t row = ret_row(b, sc, j);
      const bf16_t* qsrc = proj + row * INW + C_QB + h * 64; const bf16_t* ksrc = proj + row * INW + C_KB + h * 64;
      const u32x4 q0 = *(const u32x4*)(qsrc + 8 * q), q1 = *(const u32x4*)(qsrc + 32 + 8 * q), k0 = *(const u32x4*)(ksrc + 8 * q), k1 = *(const u32x4*)(ksrc + 32 + 8 * q);
      const u32x4* vs = (const u32x4*)(proj + row * INW + C_VB + h * 128 + 32 * q);
      u32x4 vv[4];
#pragma unroll
      for (int c = 0; c < 4; ++c) vv[c] = vs[c];
      const int d0 = q * 16;
      const u32x4* sf = (const u32x4*)((const bf16_t*)(p.ws + WS_SB16) + ((size_t)((b * 4 + h) * 2 + 0) * 130 + sc) * 8192 + j * 64 + d0);
      const u32x4* sb = (const u32x4*)((const bf16_t*)(p.ws + WS_SB16) + ((size_t)((b * 4 + h) * 2 + 1) * 130 + sc) * 8192 + j * 64 + d0);
      const u32x4 sf0 = sf[0], sf1 = sf[1], sb0 = sb[0], sb1 = sb[1];
      f32x4 tab[4];
      if (lat) rope_tab_load(rope, q, t >> 6, t & 63, tab);
      float o1[8], o2[8];
      rope_apply(q0, q1, lat, tab, o1, o2);
      *(LAS u32x4*)(lds + R2_Q + j * 144 + 16 * q) = pack8(o1); *(LAS u32x4*)(lds + R2_Q + j * 144 + 64 + 16 * q) = pack8(o2);
      rope_apply(k0, k1, lat, tab, o1, o2);
#pragma unroll
      for (int e = 0; e < 8; ++e) { o1[e] *= 0.125f; o2[e] *= 0.125f; }
      *(LAS u32x4*)(lds + R2_K + j * 144 + 16 * q) = pack8(o1); *(LAS u32x4*)(lds + R2_K + j * 144 + 64 + 16 * q) = pack8(o2);
#pragma unroll
      for (int c = 0; c < 4; ++c) *(LAS u32x4*)(lds + R2_V + j * 288 + 64 * q + 16 * c) = vv[c];
      *(LAS u32x4*)(lds + R2_SF + j * 144 + d0 * 2) = sf0; *(LAS u32x4*)(lds + R2_SF + j * 144 + d0 * 2 + 16) = sf1;
      *(LAS u32x4*)(lds + R2_SB + j * 144 + d0 * 2) = sb0; *(LAS u32x4*)(lds + R2_SB + j * 144 + d0 * 2 + 16) = sb1; }
    __syncthreads();
    bf16x8 aq[2];
#pragma unroll
    for (int ks = 0; ks < 2; ++ks) aq[ks] = *(const LAS bf16x8*)(lds + R2_Q + (16 * wave + fr) * 144 + (32 * ks + 8 * fq) * 2);
    bf16x8 pb[4];
    { const int ti_ = 16 * wave + fr; float pe[8];
#pragma unroll
      for (int nt = 0; nt < 8; ++nt) { f32x4 sv = {0.f, 0.f, 0.f, 0.f};
#pragma unroll
          for (int ks = 0; ks < 2; ++ks) { const bf16x8 bk = *(const LAS bf16x8*)(lds + R2_K + (16 * nt + fr) * 144 + (32 * ks + 8 * fq) * 2); sv = MFMA16(bk, aq[ks], sv); }
#pragma unroll
          for (int e = 0; e < 4; ++e) { const int dd = ti_ - (16 * nt + 4 * fq + e);
              const float dec = __builtin_amdgcn_exp2f(dd >= 0 ? (float)dd * l2f : (float)(-dd) * l2b);
              pe[4 * (nt & 1) + e] = sv[e] * dec; }
          if (nt & 1) pb[nt >> 1] = __builtin_bit_cast(bf16x8, pack8(pe)); } }
    f32x4 o[8];
#pragma unroll
    for (int vt = 0; vt < 8; ++vt) { f32x4 c = {0.f, 0.f, 0.f, 0.f};
#pragma unroll
        for (int pr = 0; pr < 4; ++pr) { const bf16x8 bv = tr8ab(lds + R2_V, 288, 32 * pr + 4 * fq, 32 * pr + 16 + 4 * fq, 16 * vt, fr); c = MFMA16(bv, pb[pr], c); }
        o[vt] = c; }
    const int ti = 16 * wave + fr;
    const size_t row = ret_row(b, sc, ti);
    u32x2 gt[8];
#pragma unroll
    for (int vt = 0; vt < 8; ++vt) gt[vt] = *(const u32x2*)(proj + row * INW + C_GB + h * 128 + 16 * vt + 4 * fq);
    const float wfi = exp2f((float)(ti + 1) * l2f), wbi = exp2f((float)(128 - ti) * l2b);
#pragma unroll
    for (int vt = 0; vt < 8; ++vt) { f32x4 cf = {0.f, 0.f, 0.f, 0.f}, cb = cf;
#pragma unroll
        for (int ks = 0; ks < 2; ++ks) { const bf16x8 bf = *(const LAS bf16x8*)(lds + R2_SF + (16 * vt + fr) * 144 + (32 * ks + 8 * fq) * 2); const bf16x8 bb = *(const LAS bf16x8*)(lds + R2_SB + (16 * vt + fr) * 144 + (32 * ks + 8 * fq) * 2);
            cf = MFMA16(bf, aq[ks], cf); cb = MFMA16(bb, aq[ks], cb); }
        o[vt] = o[vt] + wfi * cf + wbi * cb; }
    const float* gn = p.in[14] + l * 512 + h * 128;
    float sm = 0.f;
#pragma unroll
    for (int vt = 0; vt < 8; ++vt) sm += (o[vt][0] + o[vt][1]) + (o[vt][2] + o[vt][3]);
    sm = rows_sum(sm);
    const float mu = sm * (1.f / 128.f); float qv = 0.f;
#pragma unroll
    for (int vt = 0; vt < 8; ++vt)
#pragma unroll
        for (int e = 0; e < 4; ++e) { const float dlt = o[vt][e] - mu; qv += dlt * dlt; }
    qv = rows_sum(qv);
    const float rstd = 1.f / sqrtf(qv * (1.f / 128.f) + 1e-6f);
#pragma unroll
    for (int vt = 0; vt < 8; ++vt) { const f32x4 gv = *(const f32x4*)(gn + 16 * vt + 4 * fq);
        const float g0 = bflo(gt[vt].x), g1 = bfhi(gt[vt].x), g2 = bflo(gt[vt].y), g3 = bfhi(gt[vt].y);
        const float y0 = g0 * pg8::sigm(g0) * ((o[vt][0] - mu) * rstd * gv.x), y1 = g1 * pg8::sigm(g1) * ((o[vt][1] - mu) * rstd * gv.y);
        const float y2 = g2 * pg8::sigm(g2) * ((o[vt][2] - mu) * rstd * gv.z), y3 = g3 * pg8::sigm(g3) * ((o[vt][3] - mu) * rstd * gv.w);
        *(u32x2*)(Y + row * D + 256 + h * 128 + 16 * vt + 4 * fq) = (u32x2){pk2(y0, y1), pk2(y2, y3)}; }
    __syncthreads();
}
constexpr int S5_U = 0, S5_W = 17408, S5_WSTRIDE = 12800, S5_BU = 0, S5_X = 8448, S5_ITEMS = NB * 260 * 2;
__device__ __forceinline__ size_t s5_row(int b, int c64, int t) { return c64 < 4 ? (size_t)ML + b * CTXL + c64 * 64 + t : (size_t)b * SEQ + (c64 - 4) * 64 + t; }
__device__ __forceinline__ float gelu_tanh(float x) { const float u = 0.7978845608028654f * (x + 0.044715f * x * x * x); const float t = 1.f - 2.f / (1.f + __expf(2.f * u)); return 0.5f * x * (1.f + t); }
template <int PASS> __device__ __forceinline__ void s5_item(const Ctx cx, const Params& p, int l, int item, LAS unsigned char* lds) {
    const int tid = cx.tid, wave = tid >> 6, lane = tid & 63, fr = lane & 15, fq = lane >> 4;
    const bf16_t* proj = (const bf16_t*)(p.ws + WS_HID);
    const int go = item & 1, c64 = (item >> 1) % 260, b = (item >> 1) / 260;
    const int grp = go * 8 + wave;
    if (PASS == 1) {
#pragma unroll
        for (int rep = 0; rep < 2; ++rep) { const int ci = tid + NTHR * rep; const int t = ci >> 4, c8 = ci & 15;
            *(LAS u32x4*)(lds + S5_U + t * 272 + c8 * 16) = *(const u32x4*)(proj + s5_row(b, c64, t) * INW + C_UB + go * 128 + 8 * c8); }
        __syncthreads();
    }
    LAS unsigned char* W = lds + S5_W + wave * S5_WSTRIDE;
    LAS float* BU = (LAS float*)(W + S5_BU); LAS unsigned char* X = W + S5_X;
    const unsigned char* tb = p.ws + WS_S5T + (size_t)l * S5T_LAYER;
    f32x2 ab2_[2], e2_[2]; bf16x8 cf2_[2][4];
    if (PASS == 2) {
#pragma unroll
        for (int dir = 0; dir < 2; ++dir) {
            ab2_[dir] = ((const f32x2*)tb)[(dir * 16 + grp) * 64 + lane];
            e2_[dir] = *((const f32x2*)(p.ws + WS_S5E) + ((size_t)((b * 16 + grp) * 2 + dir) * 260 + c64) * 64 + lane);
#pragma unroll
            for (int ks = 0; ks < 4; ++ks) cf2_[dir][ks] = __builtin_bit_cast(bf16x8, *(const u32x4*)(tb + S5T_CC + (((size_t)(dir * 16 + grp) * 16 + fr) * 128 + 32 * ks + 8 * fq) * 2));
        }
    }
    f32x4 yacc[4];
#pragma unroll
    for (int i = 0; i < 4; ++i) yacc[i] = (f32x4){0.f, 0.f, 0.f, 0.f};
#pragma unroll
    for (int dir = 0; dir < 2; ++dir) {
        asm volatile("" ::: "memory");
        const f32x2 ab = (PASS == 2) ? ab2_[dir] : ((const f32x2*)tb)[(dir * 16 + grp) * 64 + lane];
        bf16x8 bbf[8];
        if (PASS == 1) {
#pragma unroll
            for (int nt = 0; nt < 8; ++nt) { u32x4 w = {0u, 0u, 0u, 0u};
                if (fq < 2) w = *(const u32x4*)(tb + S5T_BB + (((size_t)(dir * 16 + grp) * 128 + 16 * nt + fr) * 16 + 8 * fq) * 2);
                bbf[nt] = __builtin_bit_cast(bf16x8, w); }
        }
        bf16x8 cf[4];
#pragma unroll
        for (int ks = 0; ks < 4; ++ks) cf[ks] = (PASS == 2) ? cf2_[dir][ks] : __builtin_bit_cast(bf16x8, *(const u32x4*)(tb + S5T_CC + (((size_t)(dir * 16 + grp) * 16 + fr) * 128 + 32 * ks + 8 * fq) * 2));
        float xr = 0.f, xi = 0.f;
        f32x2* E = (f32x2*)(p.ws + WS_S5E) + ((size_t)((b * 16 + grp) * 2 + dir) * 260 + c64) * 64 + lane;
        if (PASS == 2) { xr = e2_[dir].x; xi = e2_[dir].y; }
#pragma unroll
        for (int sc = 0; sc < 4; ++sc) {
            asm volatile("" ::: "memory");
            const int tix = dir ? 3 - sc : sc; const int T0 = 16 * tix;
            if (PASS == 1) {
                u32x4 aw = {0u, 0u, 0u, 0u};
                if (fq < 2) aw = *(const LAS u32x4*)(lds + S5_U + (T0 + fr) * 272 + (wave * 16 + 8 * fq) * 2);
                const bf16x8 a = __builtin_bit_cast(bf16x8, aw);
#pragma unroll
                for (int nt = 0; nt < 8; ++nt) { const f32x4 c = MFMA16(bbf[nt], a, ((f32x4){0.f, 0.f, 0.f, 0.f}));
                    *(LAS f32x4*)(BU + fr * 132 + 16 * nt + 4 * fq) = c; }
                asm volatile("" ::: "memory");
            }
#pragma unroll
            for (int tt = 0; tt < 16; ++tt) { const int tl = dir ? 15 - tt : tt;
                float bur = 0.f, bui = 0.f;
                if (PASS == 1) { const f32x2 bu = *(const LAS f32x2*)(BU + tl * 132 + 2 * lane); bur = bu.x; bui = bu.y; }
                const float nr = ab.x * xr - ab.y * xi + bur, ni = ab.x * xi + ab.y * xr + bui; xr = nr; xi = ni;
                *(LAS unsigned*)(X + tl * 272 + lane * 4) = pk2(xr, xi); }
            asm volatile("" ::: "memory");
#pragma unroll
            for (int ks = 0; ks < 4; ++ks) { const bf16x8 a = *(const LAS bf16x8*)(X + fr * 272 + (32 * ks + 8 * fq) * 2); yacc[tix] = MFMA16(a, cf[ks], yacc[tix]); }
        }
        if (PASS == 1) *E = (f32x2){xr, xi};
    }
    float* s5y = (float*)(p.ws + WS_S5Y); bf16_t* G = (bf16_t*)(p.ws + WS_G);
    const float dsk = p.in[22][l * 256 + grp * 16 + fr];
    if (PASS == 2) {
        float yl[16];
#pragma unroll
        for (int ti = 0; ti < 4; ++ti)
#pragma unroll
            for (int e = 0; e < 4; ++e) yl[4 * ti + e] = s5y[s5_row(b, c64, 16 * ti + 4 * fq + e) * 256 + grp * 16 + fr];
        asm volatile("" ::: "memory");
#pragma unroll
        for (int ti = 0; ti < 4; ++ti)
#pragma unroll
            for (int e = 0; e < 4; ++e) yacc[ti][e] += yl[4 * ti + e];
    }
#pragma unroll
    for (int ti = 0; ti < 4; ++ti)
#pragma unroll
        for (int e = 0; e < 4; ++e) { const int t = 16 * ti + 4 * fq + e; const size_t row = s5_row(b, c64, t);
            if (PASS == 1) { const float u = bf1(*(const LAS bf16_t*)(lds + S5_U + t * 272 + (wave * 16 + fr) * 2)); s5y[row * 256 + grp * 16 + fr] = yacc[ti][e] + dsk * u; }
            else { G[row * 256 + grp * 16 + fr] = (bf16_t)f2bf(gelu_tanh(yacc[ti][e])); } }
    if (PASS == 1) __syncthreads();
}
#define XB_TMO      128
#define XB_XCNT(j)  (256  + 64 * (j))
#define XB_XSUB(j)  (1280 + 64 * (j))
#define XB_XGEN(j)  (2304 + 64 * (j))
#define XB_TOP      3328
#define XB_TOPGEN   3392
#define XCD_BAR_WORDS 3456
#define XB_SPIN_CAP (1u << 18)

__device__ __forceinline__ unsigned xb_ld(unsigned* p)              { return __hip_atomic_load(p, __ATOMIC_RELAXED, __HIP_MEMORY_SCOPE_AGENT); }
__device__ __forceinline__ unsigned xb_add(unsigned* p, unsigned v) { return __hip_atomic_fetch_add(p, v, __ATOMIC_RELAXED, __HIP_MEMORY_SCOPE_AGENT); }
__device__ __forceinline__ unsigned xb_xcc_id() { return (unsigned)__builtin_amdgcn_s_getreg((3 << 11) | 20) & 0xFu; }
#define XB_SPIN(cond, bar) do { unsigned _sp = 0; while (cond) { __builtin_amdgcn_s_sleep(1); \
    if ((++_sp & 255u) == 0u) { if (xb_ld(&(bar)[XB_TMO])) break; if (_sp > XB_SPIN_CAP) { atomicAdd(&(bar)[XB_TMO], 1u); break; } } } } while (0)

struct XcdBarrier {
    unsigned* bar; unsigned x;
    volatile LAS unsigned* st;
};

__device__ __forceinline__ XcdBarrier xcd_barrier_post(unsigned* bar, volatile LAS unsigned* st) {
    XcdBarrier b; b.bar = bar; b.x = xb_xcc_id(); b.st = st;
    if (threadIdx.x == 0) (void)xb_add(&bar[XB_XCNT(b.x)], 1u);
    return b;
}
__device__ __forceinline__ void xcd_barrier_complete(unsigned* bar, unsigned x, unsigned& nloc, unsigned& nx) {
    const unsigned G = gridDim.x * gridDim.y * gridDim.z;
    unsigned sum, cnt, mine, sp = 0u;
    for (;;) {
        sum = 0u; cnt = 0u; mine = 0u;
#pragma unroll
        for (unsigned j = 0; j < 16; ++j) { const unsigned c = xb_ld(&bar[XB_XCNT(j)]); sum += c; cnt += (c > 0u) ? 1u : 0u; mine = (j == x) ? c : mine; }
        if (sum == G) break;
        __builtin_amdgcn_s_sleep(1);
        if ((++sp & 255u) == 0u) { if (xb_ld(&bar[XB_TMO])) break; if (sp > XB_SPIN_CAP) { atomicAdd(&bar[XB_TMO], 1u); break; } }
    }
    nloc = mine > 0u ? mine : 1u; nx = cnt > 0u ? cnt : 1u;
}

__device__ __forceinline__ void xcd_barrier(const XcdBarrier& b) {
    asm volatile("s_waitcnt vmcnt(0)" ::: "memory");
    __syncthreads();
    if (threadIdx.x == 0) {
        unsigned* bar = b.bar;
        __builtin_amdgcn_s_waitcnt(0);
        unsigned nloc = b.st[0], nx = b.st[1];
        if (nloc == 0u) { xcd_barrier_complete(bar, b.x, nloc, nx); b.st[0] = nloc; b.st[1] = nx; }
        const unsigned old = xb_add(&bar[XB_XSUB(b.x)], 1u);
        const unsigned gen = old / nloc;
        if (old + 1u == (gen + 1u) * nloc) {
            __builtin_amdgcn_fence(__ATOMIC_RELEASE, "agent");
            asm volatile("s_waitcnt vmcnt(0)" ::: "memory");
            const unsigned og = xb_add(&bar[XB_TOP], 1u);
            const unsigned tg = og / nx;
            if (og + 1u == (tg + 1u) * nx) xb_add(&bar[XB_TOPGEN], 1u);
            else XB_SPIN(xb_ld(&bar[XB_TOPGEN]) == tg, bar);
            __builtin_amdgcn_fence(__ATOMIC_ACQUIRE, "agent");
            xb_add(&bar[XB_XGEN(b.x)], 1u);
            asm volatile("s_waitcnt vmcnt(0)" ::: "memory");
        } else {
            XB_SPIN(xb_ld(&bar[XB_XGEN(b.x)]) == gen, bar);
            __builtin_amdgcn_fence(__ATOMIC_ACQUIRE, "agent");
            asm volatile("s_waitcnt vmcnt(0)" ::: "memory");
        }
    }
    __syncthreads();
}


__global__ void __launch_bounds__(NTHR) fwd_mega(Params p_unused) {
    extern __shared__ __attribute__((aligned(16))) unsigned char lds_raw[];
    LAS unsigned char* lds = (LAS unsigned char*)lds_raw;
    cg::grid_group grid = cg::this_grid();
    volatile LAS unsigned* bst = (volatile LAS unsigned*)(lds + LDS_BYTES - 16);
    if (threadIdx.x == 0) { bst[0] = 0u; bst[1] = 0u; }
    __syncthreads();
    { const __attribute__((address_space(4))) Params* kp0 = (const __attribute__((address_space(4))) Params*)__builtin_amdgcn_kernarg_segment_ptr(); (void)xcd_barrier_post((unsigned*)(kp0->ws + WS_DIAG), bst); }
    int dup_done = 0;
#pragma unroll 1
    for (int ph = 0; ph < 1 + 13 * DEPTH; ++ph) {
        const __attribute__((address_space(4))) Params* kp = (const __attribute__((address_space(4))) Params*)__builtin_amdgcn_kernarg_segment_ptr();
        asm volatile("" : "+s"(kp));
        const Params& p = *(const Params*)kp;
        Ctx cx; { int t_ = threadIdx.x, b_ = blockIdx.x, n_ = gridDim.x; asm volatile("" : "+v"(t_)); asm volatile("" : "+s"(b_), "+s"(n_)); cx.tid = t_; cx.bid = b_; cx.nb = n_; }
        unsigned char* ws = p.ws;
        float* XL = p.out; float* XC = (float*)(ws + WS_XC);
        bf16_t* H = (bf16_t*)(ws + WS_H); bf16_t* Y = (bf16_t*)(ws + WS_Y); bf16_t* HID = (bf16_t*)(ws + WS_HID); bf16_t* G = (bf16_t*)(ws + WS_G);
        const unsigned char* wb = ws + ((((ph - 1) / 13) & 1) ? WS_WB2 : WS_WB);
        if (ph == 0) {
#ifndef NO_P0
            phase_modv(cx, p, lds); phase_tables(cx, p); phase_conv(cx, p, 0, lds);
            for (int i = cx.bid * NTHR + cx.tid; i < MC * D / 4; i += cx.nb * NTHR) ((f32x4*)XC)[i] = ((const f32x4*)p.in[2])[i];
#endif
        }
        else {
            const int l = (ph - 1) / 13, k = (ph - 1) % 13;
            const float* modl = (const float*)(ws + WS_MODV) + (size_t)l * 3 * 9216;
            const float* xl_in = l == 0 ? p.in[0] : XL; const float* xc_in = XC;
            if (k == 0 || k == 3 || k == 10) {
#ifndef NO_NORM
                phase_norm(cx, k == 0 ? xl_in : XL, XC, modl, k == 0 ? 0 : (k == 3 ? 3 : 6), k == 0 ? 1 : (k == 3 ? 4 : 7), H, (const float*)(ws + WS_S5Y), k == 0 ? (l > 0 ? 11 : 0) : (k == 3 ? 11 : 8), (l == DEPTH - 1 && k == 10) ? ML : MT);
#endif
            } else if (k == 5) {
                for (int it = cx.bid; it < NA_ITEMS + S5_ITEMS + RET_ITEMS; it += cx.nb) {
                    Ctx cx0 = cx; asm volatile("" : "+v"(cx0.tid)); const Ctx cx = cx0;
#ifdef PROBE_ONLY
                    const int only = dup_done ? PROBE_ONLY : 0;
#else
                    const int only = 0;
#endif
                    if (it < NA_ITEMS) { if ((only == 0 || only == 1) && !(l == DEPTH - 1 && it >= NA_LAT_ITEMS)) {
#ifdef PROBE_NA_STAGE_ONLY
                        na_item(cx, p, l, it, lds, dup_done);
#else
                        na_item(cx, p, l, it, lds);
#endif
                    } }
                    else if (it < NA_ITEMS + S5_ITEMS) { if (only == 0 || only == 2) s5_item<1>(cx, p, l, it - NA_ITEMS, lds); }
                    else { if (only == 0 || only == 3) ret_kv_item(cx, p, l, it - NA_ITEMS - S5_ITEMS, lds); }
                }
            } else if (k == 6) {
                phase_scans(cx, p, l);
                if (l + 1 < DEPTH) phase_conv(cx, p, l + 1, lds);
            } else if (k == 7) {
                for (int it = cx.bid; it < RET_ITEMS + S5_ITEMS; it += cx.nb) {
                    Ctx cx0 = cx; asm volatile("" : "+v"(cx0.tid)); const Ctx cx = cx0;
#ifdef PROBE_ONLY
                    const int only = dup_done ? PROBE_ONLY : 0;
#else
                    const int only = 0;
#endif
                    if (it < RET_ITEMS) { if (only == 0 || only == 1) ret_out_item(cx, p, l, it, lds); }
                    else { if (only == 0 || only == 2) s5_item<2>(cx, p, l, it - RET_ITEMS, lds); }
                }
            } else {
                const bool f_in = (k == 1 || k == 11), f_out = (k == 2 || k == 12);
                const bf16_t* gA = f_in ? H : f_out ? HID : (k == 4 ? H : (k == 8 ? G : Y));
                const size_t wo = k == 1 ? WB_F1IN : k == 11 ? WB_F2IN : k == 2 ? WB_F1OUT : k == 12 ? WB_F2OUT : k == 4 ? WB_WIN : k == 8 ? WB_GLU : WB_WOUT;
                const int gN = f_in ? 2 * DFF : (k == 4 ? INW : (k == 8 ? 512 : D));
                const int gK = f_out ? DFF : (k == 8 ? 256 : D);
                const int etype = f_in ? 0 : (k == 4 ? 2 : (k == 8 ? 1 : 3));
                bf16_t* eO = k == 8 ? Y : HID; const int eldc = k == 4 ? INW : (k == 8 ? D : DFF); const int ecol = k == 8 ? 768 : 0;
                const float* egate = modl + (k == 2 ? 2 : (k == 12 ? 8 : 5)) * 1024;
#ifdef PROBE_DUP_K
                const float ecoef = (k == PROBE_DUP_K && !dup_done) ? 0.f : (k == 9 ? 1.0f : 0.5f);
#else
                const float ecoef = k == 9 ? 1.0f : 0.5f;
#endif

                const float* exin_l = k == 2 ? xl_in : XL;
                const pg8::Gemm g{gA, (const bf16_t*)(wb + wo), MT, gN, gK};
                const pg8::EpiAny E{etype, eldc, ecol, ecoef, eO, exin_l, XL, XC, XC, egate, (float*)(ws + WS_S5Y)};
                pg8::Order S; S.init(g.N, g.K, cx.nb, cx.bid, E.type == 3 ? (g.K == D ? 2 : 4) : 0, (l == DEPTH - 1 && k >= 8) ? 1 : 0);
#ifndef NO_GEMM
                pg8::gemm_phase<pg8::EpiAny, pg8::Order, true, true>(lds, g, S, E, cx.tid);
#endif
            }
        }
        if (ph == 0) grid.sync();
        else { XcdBarrier xb_; xb_.bar = (unsigned*)(ws + WS_DIAG); xb_.x = xb_xcc_id(); xb_.st = bst; xcd_barrier(xb_); }
#ifdef PROBE_DUP_MIX
        if (ph > 0 && (ph - 1) % 13 == 8 && !dup_done) { dup_done = 1; ph -= 4; } else if (ph > 0 && (ph - 1) % 13 == 8) dup_done = 0;
#endif
#ifdef PROBE_DUP_K
        if (ph > 0 && ((ph - 1) % 13 == PROBE_DUP_K) && !dup_done) { dup_done = 1; ph -= 1; } else dup_done = 0;
#endif
    }
}
extern "C" void kernel_launch(void* const* d_in, const int* in_sizes, int n_in, void* d_out, int out_size, void* d_ws, size_t ws_size, hipStream_t stream) {
    static int grid = 0;
    if (grid == 0) {
        if (n_in != 26 || out_size != ML * D || ws_size < WS_END) { fprintf(stderr, "kernel_launch: unexpected shapes: n_in %d out %d ws %zu (need %zu)\n", n_in, out_size, ws_size, (size_t)WS_END); grid = -1; return; }
        int dev = 0, cus = 0, per_cu = 0;
        hipGetDevice(&dev); hipDeviceGetAttribute(&cus, hipDeviceAttributeMultiprocessorCount, dev);
        if (hipFuncSetAttribute((const void*)fwd_mega, hipFuncAttributeMaxDynamicSharedMemorySize, LDS_BYTES) != hipSuccess) { fprintf(stderr, "kernel_launch: hipFuncSetAttribute failed\n"); grid = -1; return; }
        if (hipOccupancyMaxActiveBlocksPerMultiprocessor(&per_cu, (const void*)fwd_mega, NTHR, LDS_BYTES) != hipSuccess || per_cu < 1) { fprintf(stderr, "kernel_launch: occupancy query gave %d\n", per_cu); per_cu = 1; }
        (void)hipGetLastError();
        grid = cus * per_cu;
    }
    if (grid < 0) return;
    Params prm{};
    for (int i = 0; i < 26; ++i) prm.in[i] = (const float*)d_in[i];
    prm.out = (float*)d_out; prm.ws = (unsigned char*)d_ws;
    if (hipMemsetAsync(d_ws, 0, 16384, stream) != hipSuccess) { fprintf(stderr, "kernel_launch: memset of barrier words failed\n"); return; }
    void* args[] = {&prm};
    hipError_t e = hipLaunchCooperativeKernel((const void*)fwd_mega, dim3(grid), dim3(NTHR), args, LDS_BYTES, stream);
    if (e != hipSuccess) fprintf(stderr, "cooperative launch failed: %s (grid %d)\n", hipGetErrorString(e), grid);
}
```

```cpp
#include <hip/hip_runtime.h>
#include <hip/hip_cooperative_groups.h>
#include <cstdio>
#include <cstdint>
namespace cg = cooperative_groups;
namespace pg8 {
#define PG8_LAS __attribute__((address_space(3)))
typedef unsigned short bf16_t;
typedef short bf16x8 __attribute__((ext_vector_type(8)));
typedef float f32x4 __attribute__((ext_vector_type(4)));
typedef unsigned u32x4 __attribute__((ext_vector_type(4)));
constexpr int BM = 256, BK = 64, HALF = 128, HTB = HALF * BK * 2  , STAGE_BYTES = 8 * HTB, NXCD = 8, WGM = 8;

__host__ __device__ __forceinline__ int lds_byte(int r, int c) { const int st = (r >> 4) * 2 + (c >> 5), rr = r & 15, cc = c & 31, ob = rr * 64 + cc * 2; return st * 1024 + (ob ^ (((ob >> 9) & 1) << 5)); }
__host__ __device__ __forceinline__ void stage_rc(int b, int& R, int& C) { const int st = b / 1024, sb = b % 1024, swz = sb ^ (((sb >> 9) & 1) << 5); R = (st >> 1) * 16 + swz / 64; C = (st & 1) * 32 + (swz % 64) / 2; }
__host__ __device__ __forceinline__ int perm32(int rho) { const int n = rho >> 4, i = rho & 15; return 8 * (i >> 2) + 4 * n + (i & 3); }

struct Unit { int pm, pn, k0, nt, split; };
struct Gemm { const bf16_t* A; const bf16_t* Bt; int M, N, K; };

struct StaticOrder {
    int nM, nN, nwg, G, c;
    __host__ __device__ void init(int M, int N, int G_, int c_) { nM = M / BM; nN = N / BM; nwg = nM * nN; G = G_; c = c_; }
    __host__ __device__ bool next(int i, Unit& u) const {
        const long L = (long)i * G + c; if (L >= nwg) return false;
        int wgid = (int)L; { const int q = nwg / NXCD, r = nwg % NXCD, xcd = wgid % NXCD, off = wgid / NXCD; wgid = (xcd < r ? xcd * (q + 1) : r * (q + 1) + (xcd - r) * q) + off; }
        const int nig = WGM * nN, gid = wgid / nig, fm = gid * WGM, gsz = (nM - fm) < WGM ? (nM - fm) : WGM;
        u.pm = fm + ((wgid % nig) % gsz); u.pn = (wgid % nig) / gsz; return true;
    }
    __device__ __forceinline__ void a_ready(const Unit&) const {}
    __device__ __forceinline__ void done(const Unit&) const {}
};

__device__ __forceinline__ unsigned cvt_pk_bf16(float lo, float hi) { unsigned r; asm volatile("v_cvt_pk_bf16_f32 %0, %1, %2" : "=v"(r) : "v"(lo), "v"(hi)); return r; }
struct Order {
    int nN, nLat, G, c, ntK, split_nt, nch;
    int no_ctx;
    __device__ __forceinline__ void init(int N, int K, int G_, int c_, int split_nt_, int no_ctx_) { nN = N / BM; nLat = 128 * nN; G = G_; c = c_; ntK = K / BK; split_nt = split_nt_; nch = split_nt_ ? ntK / split_nt_ : 1; no_ctx = no_ctx_; }
    __device__ __forceinline__ bool next(int i, Unit& u) const {
        const long L = (long)i * G + c;
        if (L < nLat) {
            int wgid = (int)L; { const int nwg = nLat, q = nwg / NXCD, r = nwg % NXCD, xcd = wgid % NXCD, off = wgid / NXCD; wgid = (xcd < r ? xcd * (q + 1) : r * (q + 1) + (xcd - r) * q) + off; }
            const int nM = 128, nig = WGM * nN, gid = wgid / nig, fm = gid * WGM, gsz = (nM - fm) < WGM ? (nM - fm) : WGM;
            u.pm = fm + ((wgid % nig) % gsz); u.pn = (wgid % nig) / gsz; u.k0 = 0; u.nt = ntK; u.split = 0; return true;
        }
        const int j = (int)(L - nLat);
        if (no_ctx || j >= 2 * nN * nch) return false;
        const int tile = j / nch, ch = j - tile * nch;
        u.pm = 128 + tile / nN; u.pn = tile % nN; u.k0 = ch * split_nt * BK; u.nt = split_nt ? split_nt : ntK; u.split = split_nt ? 1 : 0; return true;
    }
    __device__ __forceinline__ void a_ready(const Unit&) const {}
    __device__ __forceinline__ void done(const Unit&) const {}
};
__device__ __forceinline__ float sigm(float x) { return __builtin_amdgcn_rcpf(1.f + __expf(-x)); }
struct EpiAny {
    static constexpr bool PERM = true, AFTER_DRAIN = false;
    int type, ldc, col_off; float coef; bf16_t* O;
    const float* xin_l; float* xout_l; const float* xin_c; float* xout_c; const float* gate; float* part;
    __device__ __forceinline__ void operator()(const f32x4 (&acc)[2][2][4][2], const Unit& u, int wr, int wc, int fr, int fq) const {
        if (type <= 1) {
            const int row0 = u.pm * BM + wr * 64 + fr; const int col0 = col_off + u.pn * HALF + wc * 32 + 8 * fq;
#pragma unroll
            for (int ai = 0; ai < 2; ++ai)
#pragma unroll
                for (int m = 0; m < 4; ++m) {
                    bf16_t* rowp = O + (size_t)(row0 + ai * HALF + m * 16) * ldc + col0;
                    float r[8];
#pragma unroll
                    for (int n = 0; n < 2; ++n)
#pragma unroll
                        for (int e = 0; e < 4; ++e) { const float a = acc[ai][0][m][n][e], b = acc[ai][1][m][n][e]; r[4 * n + e] = (type == 0) ? a * sigm(a) * b : a * sigm(b); }
                    u32x4 w; w.x = cvt_pk_bf16(r[0], r[1]); w.y = cvt_pk_bf16(r[2], r[3]); w.z = cvt_pk_bf16(r[4], r[5]); w.w = cvt_pk_bf16(r[6], r[7]);
                    *(u32x4*)rowp = w;
                }
        } else if (type == 2) {
            const int row0 = u.pm * BM + wr * 64 + fr; const int col0 = u.pn * BM + wc * 32 + 8 * fq;
#pragma unroll
            for (int ai = 0; ai < 2; ++ai)
#pragma unroll
                for (int m = 0; m < 4; ++m) {
                    bf16_t* rowp = O + (size_t)(row0 + ai * HALF + m * 16) * ldc + col0;
#pragma unroll
                    for (int bj = 0; bj < 2; ++bj) { const f32x4 v0 = acc[ai][bj][m][0], v1 = acc[ai][bj][m][1];
                        u32x4 w; w.x = cvt_pk_bf16(v0[0], v0[1]); w.y = cvt_pk_bf16(v0[2], v0[3]); w.z = cvt_pk_bf16(v1[0], v1[1]); w.w = cvt_pk_bf16(v1[2], v1[3]);
                        *(u32x4*)(rowp + bj * HALF) = w; }
                }
        } else {
            const bool isc = u.pm >= 128; const int mi = isc ? 2 : (u.pm >> 6);
            const size_t rbase = isc ? (size_t)(u.pm - 128) * 256 : (size_t)u.pm * 256;
            const float* xi = isc ? xin_c : xin_l; float* xo = isc ? xout_c : xout_l;
            const float* gv = gate + mi * 9216;
            const int row0 = wr * 64 + fr, col0 = u.pn * BM + wc * 32 + 8 * fq;
#pragma unroll
            for (int bj = 0; bj < 2; ++bj) {
                const int c = col0 + bj * HALF;
                const f32x4 g0 = *(const f32x4*)(gv + c) * coef, g1 = *(const f32x4*)(gv + c + 4) * coef;
#pragma unroll
                for (int ai = 0; ai < 2; ++ai) {
                    if (u.split) {
                        const int ch = u.k0 / (u.nt * BK);
#pragma unroll
                        for (int m = 0; m < 4; ++m) { float* dst = part + (size_t)ch * (512 * 1024) + (rbase + row0 + ai * HALF + m * 16) * 1024 + c;
                            *(f32x4*)dst = g0 * acc[ai][bj][m][0]; *(f32x4*)(dst + 4) = g1 * acc[ai][bj][m][1]; }
                    } else {
                        f32x4 xv[4][2];
#pragma unroll
                        for (int m = 0; m < 4; ++m) { const float* src = xi + (rbase + row0 + ai * HALF + m * 16) * 1024 + c; xv[m][0] = *(const f32x4*)src; xv[m][1] = *(const f32x4*)(src + 4); }
                        asm volatile("" ::: "memory");
#pragma unroll
                        for (int m = 0; m < 4; ++m) { float* dst = xo + (rbase + row0 + ai * HALF + m * 16) * 1024 + c;
                            *(f32x4*)dst = xv[m][0] + g0 * acc[ai][bj][m][0]; *(f32x4*)(dst + 4) = xv[m][1] + g1 * acc[ai][bj][m][1]; }
                    }
                }
            }
        }
    }
};
template <class Epi, class Sched, bool ALIGN_EPI = false, bool SP2 = false>
__device__ __forceinline__ void gemm_phase(PG8_LAS unsigned char* lds, const Gemm g, const Sched& S, const Epi& E, const int tid_in) {
    const int tid = tid_in, wid = __builtin_amdgcn_readfirstlane(tid >> 6), lane = tid & 63, wr = wid >> 2, wc = wid & 3, fr = lane & 15, fq = lane >> 4;
    const int K = g.K;
    unsigned voffA[2], voffB[2];
#pragma unroll
    for (int i = 0; i < 2; ++i) { int R, C; stage_rc(tid * 16 + i * 8192, R, C); const int Rb = Epi::PERM ? ((R & ~31) + perm32(R & 31)) : R;
        voffA[i] = (unsigned)(R * K + C) * 2u; voffB[i] = (unsigned)(Rb * K + C) * 2u; }
    const size_t kstep = (size_t)(BK * 2);
    const size_t hstep = (size_t)HALF * K * 2;
    const size_t tstep = 2 * hstep;
    const unsigned ldsw = (unsigned)wid * 1024u;
    const int aoff = lds_byte(wr * 64 + fr, fq * 8), boff = lds_byte(wc * 32 + fr, fq * 8);
#define PG8_SA(b, h) (((b) * 2 + (h)) * HTB)
#define PG8_SB(b, h) ((4 + (b) * 2 + (h)) * HTB)
#define PG8_STAGE(bufoff, gbase, voff) do { _Pragma("unroll") for (int _i = 0; _i < 2; ++_i) \
        __builtin_amdgcn_global_load_lds((const unsigned*)((const char*)(gbase) + (voff)[_i]), (PG8_LAS unsigned*)(lds + (bufoff) + ldsw + _i * 8192), 16, 0, 0); } while (0)
#define PG8_LDA(dst, b, h) do { _Pragma("unroll") for (int m = 0; m < 4; ++m) _Pragma("unroll") for (int k = 0; k < 2; ++k) dst[m][k] = *(const PG8_LAS bf16x8*)(lds + PG8_SA(b, h) + aoff + m * 2048 + k * 1024); } while (0)
#define PG8_LDB(dst, b, h) do { _Pragma("unroll") for (int n = 0; n < 2; ++n) _Pragma("unroll") for (int k = 0; k < 2; ++k) dst[n][k] = *(const PG8_LAS bf16x8*)(lds + PG8_SB(b, h) + boff + n * 2048 + k * 1024); } while (0)
#define PG8_MMA(ai, bj, At, Bt) do { __builtin_amdgcn_s_setprio(1); _Pragma("unroll") for (int m = 0; m < 4; ++m) _Pragma("unroll") for (int n = 0; n < 2; ++n) _Pragma("unroll") for (int k = 0; k < 2; ++k) \
        acc[ai][bj][m][n] = __builtin_amdgcn_mfma_f32_16x16x32_bf16(Bt[n][k], At[m][k], acc[ai][bj][m][n], 0, 0, 0); __builtin_amdgcn_s_setprio(0); } while (0)
#define PG8_WAIT_V(n) asm volatile("s_waitcnt vmcnt(" #n ")" ::: "memory")
#define PG8_WAIT_L(n) asm volatile("s_waitcnt lgkmcnt(" #n ")" ::: "memory")
#define PG8_BAR __builtin_amdgcn_s_barrier()
#define PG8_SCHED __builtin_amdgcn_sched_barrier(0)
    Unit cur, nxt; int ui = 0;
    if (!S.next(0, cur)) return;
    f32x4 acc[2][2][4][2];
#pragma unroll
    for (int a = 0; a < 2; ++a)
#pragma unroll
        for (int b = 0; b < 2; ++b)
#pragma unroll
            for (int m = 0; m < 4; ++m)
#pragma unroll
                for (int n = 0; n < 2; ++n) acc[a][b][m][n] = (f32x4){0.f, 0.f, 0.f, 0.f};
    bf16x8 At[4][2], B0[2][2], B1[2][2];
    const char* cA = (const char*)g.A + (size_t)cur.pm * tstep + (size_t)cur.k0 * 2; const char* cB = (const char*)g.Bt + (size_t)cur.pn * tstep + (size_t)cur.k0 * 2;
    S.a_ready(cur);
    if constexpr (SP2) {
        PG8_STAGE(PG8_SB(0, 0), cB, voffB); PG8_STAGE(PG8_SB(0, 1), cB + hstep, voffB); PG8_STAGE(PG8_SA(0, 0), cA, voffA); PG8_STAGE(PG8_SA(0, 1), cA + hstep, voffA);
        if (wr == 1) PG8_BAR;
        PG8_WAIT_V(2); PG8_BAR;
        PG8_STAGE(PG8_SB(1, 0), cB + kstep, voffB); PG8_STAGE(PG8_SA(1, 0), cA + kstep, voffA); PG8_STAGE(PG8_SB(1, 1), cB + hstep + kstep, voffB);
        PG8_WAIT_V(6); PG8_BAR;
    } else {
        PG8_STAGE(PG8_SB(0, 0), cB, voffB); PG8_STAGE(PG8_SA(0, 0), cA, voffA); PG8_STAGE(PG8_SB(0, 1), cB + hstep, voffB); PG8_STAGE(PG8_SA(0, 1), cA + hstep, voffA);
        if (wr == 1) PG8_BAR;
        PG8_WAIT_V(4); PG8_BAR;
        PG8_STAGE(PG8_SB(1, 0), cB + kstep, voffB); PG8_STAGE(PG8_SA(1, 0), cA + kstep, voffA); PG8_STAGE(PG8_SB(1, 1), cB + hstep + kstep, voffB);
        PG8_WAIT_V(6); PG8_BAR;
    }
    for (;;) {
        const bool has_next = S.next(ui + 1, nxt);
        const char* nA = has_next ? (const char*)g.A + (size_t)nxt.pm * tstep + (size_t)nxt.k0 * 2 : cA; const char* nB = has_next ? (const char*)g.Bt + (size_t)nxt.pn * tstep + (size_t)nxt.k0 * 2 : cB;
        const int nt = cur.nt;
        for (int t = 0; t < nt; t += 2) {
            const bool last = (t == nt - 2);
            const char* a1 = cA + (size_t)(t + 1) * kstep;
            const char* a2 = last ? nA : cA + (size_t)(t + 2) * kstep; const char* b2 = last ? nB : cB + (size_t)(t + 2) * kstep;
            const char* a3 = a2 + kstep; const char* b3 = b2 + kstep;
            if (last && has_next) S.a_ready(nxt);
            if constexpr (SP2) {
            PG8_LDB(B0, 0, 0); PG8_LDB(B1, 0, 1); PG8_SCHED; PG8_LDA(At, 0, 0); PG8_STAGE(PG8_SA(1, 1), a1 + hstep, voffA);
            PG8_WAIT_V(8); PG8_WAIT_L(0); PG8_BAR; PG8_MMA(0, 0, At, B0); PG8_MMA(0, 1, At, B1); PG8_BAR; PG8_SCHED;
            PG8_LDA(At, 0, 1); PG8_STAGE(PG8_SB(0, 0), b2, voffB); PG8_STAGE(PG8_SB(0, 1), b2 + hstep, voffB); PG8_STAGE(PG8_SA(0, 0), a2, voffA);
            PG8_WAIT_V(8); PG8_WAIT_L(0); PG8_BAR; PG8_MMA(1, 0, At, B0); PG8_MMA(1, 1, At, B1); PG8_BAR; PG8_SCHED;
            PG8_LDB(B0, 1, 0); PG8_LDB(B1, 1, 1); PG8_SCHED; PG8_LDA(At, 1, 0); PG8_STAGE(PG8_SA(0, 1), a2 + hstep, voffA);
            PG8_WAIT_V(8); PG8_WAIT_L(0); PG8_BAR; PG8_MMA(0, 0, At, B0); PG8_MMA(0, 1, At, B1); PG8_BAR; PG8_SCHED;
            PG8_LDA(At, 1, 1); PG8_STAGE(PG8_SB(1, 0), b3, voffB); PG8_STAGE(PG8_SB(1, 1), b3 + hstep, voffB); PG8_STAGE(PG8_SA(1, 0), a3, voffA);
            PG8_WAIT_V(8); PG8_WAIT_L(0); PG8_BAR; PG8_MMA(1, 0, At, B0); PG8_MMA(1, 1, At, B1); PG8_BAR; PG8_SCHED;
            } else {
            PG8_LDB(B0, 0, 0); PG8_SCHED; PG8_LDA(At, 0, 0); PG8_STAGE(PG8_SA(1, 1), a1 + hstep, voffA);
            PG8_WAIT_L(8); PG8_BAR; PG8_WAIT_L(0); PG8_MMA(0, 0, At, B0); PG8_BAR; PG8_SCHED;
            PG8_LDB(B1, 0, 1); PG8_STAGE(PG8_SB(0, 0), b2, voffB);
            PG8_BAR; PG8_WAIT_L(0); PG8_MMA(0, 1, At, B1); PG8_BAR;
            PG8_LDA(At, 0, 1); PG8_STAGE(PG8_SA(0, 0), a2, voffA);
            PG8_BAR; PG8_WAIT_L(0); PG8_MMA(1, 0, At, B0); PG8_BAR; PG8_SCHED;
            PG8_STAGE(PG8_SB(0, 1), b2 + hstep, voffB);
            PG8_WAIT_V(6); PG8_BAR; PG8_MMA(1, 1, At, B1); PG8_BAR;
            PG8_LDB(B0, 1, 0); PG8_SCHED; PG8_LDA(At, 1, 0); PG8_STAGE(PG8_SA(0, 1), a2 + hstep, voffA);
            PG8_WAIT_L(8); PG8_BAR; PG8_WAIT_L(0); PG8_MMA(0, 0, At, B0); PG8_BAR; PG8_SCHED;
            PG8_LDB(B1, 1, 1); PG8_STAGE(PG8_SB(1, 0), b3, voffB);
            PG8_BAR; PG8_WAIT_L(0); PG8_MMA(0, 1, At, B1); PG8_BAR;
            PG8_LDA(At, 1, 1); PG8_STAGE(PG8_SA(1, 0), a3, voffA);
            PG8_BAR; PG8_WAIT_L(0); PG8_MMA(1, 0, At, B0); PG8_BAR; PG8_SCHED;
            PG8_STAGE(PG8_SB(1, 1), b3 + hstep, voffB);
            PG8_WAIT_V(6); PG8_BAR; PG8_MMA(1, 1, At, B1); PG8_BAR;
            }
        }
        if constexpr (ALIGN_EPI) { if (wr == 0) PG8_BAR; }
        if constexpr (!Epi::AFTER_DRAIN) { E(acc, cur, wr, wc, fr, fq); S.done(cur); }
        if (!has_next) break;
#pragma unroll
        for (int a = 0; a < 2; ++a)
#pragma unroll
            for (int b = 0; b < 2; ++b)
#pragma unroll
                for (int m = 0; m < 4; ++m)
#pragma unroll
                    for (int n = 0; n < 2; ++n) acc[a][b][m][n] = (f32x4){0.f, 0.f, 0.f, 0.f};
        cur = nxt; cA = nA; cB = nB; ++ui;
        if constexpr (ALIGN_EPI) { if (wr == 1) PG8_BAR; }
    }
    PG8_WAIT_V(0);
    if constexpr (!ALIGN_EPI) { if (wr == 0) PG8_BAR; }
    PG8_BAR;
    if constexpr (Epi::AFTER_DRAIN) { E.fused(acc, cur, wr, wc, fr, fq, lds, wid, lane); S.done(cur); }
#undef PG8_SA
#undef PG8_SB
#undef PG8_STAGE
#undef PG8_LDA
#undef PG8_LDB
#undef PG8_MMA
#undef PG8_WAIT_V
#undef PG8_WAIT_L
#undef PG8_BAR
#undef PG8_SCHED
}
}
#define LAS __attribute__((address_space(3)))
typedef pg8::bf16_t bf16_t;
typedef pg8::bf16x8 bf16x8;
typedef pg8::f32x4 f32x4;
typedef pg8::u32x4 u32x4;
typedef unsigned u32x2 __attribute__((ext_vector_type(2)));
typedef float f32x2 __attribute__((ext_vector_type(2)));

constexpr int D = 1024, NB = 2, SEQ = 16384, DEPTH = 4, CTXL = 256, DFF = 2816;
constexpr int ML = NB * SEQ, MC = NB * CTXL, MT = ML + MC;
constexpr int INW = 2560, C_QA = 0, C_KA = 256, C_VA = 512, C_QB = 768, C_KB = 1024, C_VB = 1280, C_GB = 1792, C_UB = 2304;
constexpr int NTHR = 512, NWAVE = 8;
constexpr int LDS_BYTES = 147456;
constexpr size_t MiB = 1u << 20;
constexpr size_t WS_DIAG = 0, WS_MODV = 1 * MiB, WS_ROPE = 2 * MiB, WS_S5T = 3 * MiB, WS_XC = 6 * MiB, WS_H = 8 * MiB, WS_Y = 73 * MiB, WS_HID = 138 * MiB,
                 WS_WB = 317 * MiB, WS_KV = 358 * MiB, WS_S5Y = 423 * MiB, WS_S5E = 456 * MiB, WS_G = 465 * MiB, WS_WB2 = 482 * MiB, WS_SB16 = 523 * MiB, WS_END = 556 * MiB;
constexpr size_t S5T_LAYER = 512 * 1024, S5T_ABL = 16384, S5T_BB = 32768, S5T_CC = 163840;
constexpr size_t WB_F1IN = 0, WB_F1OUT = 11 * MiB, WB_WIN = WB_F1OUT + 5767168, WB_WOUT = WB_WIN + 5 * MiB, WB_F2IN = WB_WOUT + 2 * MiB, WB_F2OUT = WB_F2IN + 11 * MiB, WB_GLU = WB_F2OUT + 5767168;
static_assert(WB_GLU + 262144 <= 41 * MiB, "weights map");

struct Params { const float* in[26]; float* out; unsigned char* ws; };
struct Ctx { int tid, bid, nb; };

__device__ __forceinline__ unsigned pk2(float lo, float hi) { unsigned r; asm("v_cvt_pk_bf16_f32 %0, %1, %2" : "=v"(r) : "v"(lo), "v"(hi)); return r; }
__device__ __forceinline__ unsigned f2bf(float f) { return pk2(f, f) & 0xffffu; }
__device__ __forceinline__ float bflo(unsigned u) { return __builtin_bit_cast(float, u << 16); }
__device__ __forceinline__ float bfhi(unsigned u) { return __builtin_bit_cast(float, u & 0xffff0000u); }
__device__ __forceinline__ float bf1(bf16_t h) { return __builtin_bit_cast(float, (unsigned)h << 16); }
__device__ __forceinline__ void unpack8(const u32x4 v, float* o) { o[0] = bflo(v.x); o[1] = bfhi(v.x); o[2] = bflo(v.y); o[3] = bfhi(v.y); o[4] = bflo(v.z); o[5] = bfhi(v.z); o[6] = bflo(v.w); o[7] = bfhi(v.w); }
__device__ __forceinline__ u32x4 pack8(const float* o) { u32x4 w; w.x = pk2(o[0], o[1]); w.y = pk2(o[2], o[3]); w.z = pk2(o[4], o[5]); w.w = pk2(o[6], o[7]); return w; }
__device__ __forceinline__ float wave_sum(float v) {
#pragma unroll
    for (int o = 1; o < 64; o <<= 1) v += __shfl_xor(v, o);
    return v;
}
__device__ __forceinline__ float rows_sum(float v) {
    unsigned u = __builtin_bit_cast(unsigned, v);
    auto a = __builtin_amdgcn_permlane16_swap(u, u, false, false);
    const float s = __builtin_bit_cast(float, (unsigned)a[0]) + __builtin_bit_cast(float, (unsigned)a[1]);
    u = __builtin_bit_cast(unsigned, s);
    auto b = __builtin_amdgcn_permlane32_swap(u, u, false, false);
    return __builtin_bit_cast(float, (unsigned)b[0]) + __builtin_bit_cast(float, (unsigned)b[1]);
}
__device__ __forceinline__ float rows_max(float v) {
    unsigned u = __builtin_bit_cast(unsigned, v);
    auto a = __builtin_amdgcn_permlane16_swap(u, u, false, false);
    const float s = fmaxf(__builtin_bit_cast(float, (unsigned)a[0]), __builtin_bit_cast(float, (unsigned)a[1]));
    u = __builtin_bit_cast(unsigned, s);
    auto b = __builtin_amdgcn_permlane32_swap(u, u, false, false);
    return fmaxf(__builtin_bit_cast(float, (unsigned)b[0]), __builtin_bit_cast(float, (unsigned)b[1]));
}
__device__ __forceinline__ float log_sigmoid(float x) { return -log1pf(expf(-x)); }
#define MFMA16(a, b, c) __builtin_amdgcn_mfma_f32_16x16x32_bf16((a), (b), (c), 0, 0, 0)
typedef short v4i16_t __attribute__((ext_vector_type(4)));
__device__ __forceinline__ u32x2 tr4(const LAS unsigned char* p) { return __builtin_bit_cast(u32x2, __builtin_amdgcn_ds_read_tr16_b64_v4i16((LAS v4i16_t*)p)); }
__device__ __forceinline__ bf16x8 tr8(const LAS unsigned char* base, int stride, int r0, int c0, int fr) {
    const LAS unsigned char* p = base + (r0 + (fr >> 2)) * stride + (c0 + 4 * (fr & 3)) * 2;
    const u32x2 lo = tr4(p), hi = tr4(p + 4 * stride);
    return __builtin_bit_cast(bf16x8, ((u32x4){lo.x, lo.y, hi.x, hi.y}));
}
__device__ __forceinline__ bf16x8 tr8ab(const LAS unsigned char* base, int stride, int rA, int rB, int c0, int fr) {
    const int ro = fr >> 2, co = (c0 + 4 * (fr & 3)) * 2;
    const u32x2 lo = tr4(base + (rA + ro) * stride + co), hi = tr4(base + (rB + ro) * stride + co);
    return __builtin_bit_cast(bf16x8, ((u32x4){lo.x, lo.y, hi.x, hi.y}));
}

__device__ __forceinline__ void phase_modv(const Ctx cx, const Params& p, LAS unsigned char* lds) {
    LAS float* sv = (LAS float*)lds;
    LAS float* red = (LAS float*)(lds + 12288);
    const int tid = cx.tid;
    for (int i = tid; i < 3072; i += NTHR) { const int which = i >> 10, k = i & 1023; const float c = which < 2 ? p.in[1][which * 1024 + k] : p.in[3][k]; sv[i] = c / (1.f + expf(-c)); }
    __syncthreads();
    float* modv = (float*)(p.ws + WS_MODV);
    const int kg = tid >> 4, cq = tid & 15;
    for (int item = cx.bid; item < 576; item += cx.nb) {
        const int l = item / 144, n0 = (item % 144) * 64;
        const float* W = p.in[4] + (size_t)l * 1024 * 9216 + n0 + 4 * cq;
        f32x4 a0 = {0.f, 0.f, 0.f, 0.f}, a1 = a0, a2 = a0;
#pragma unroll 8
        for (int kk = 0; kk < 32; ++kk) { const int k = kg * 32 + kk; const f32x4 w = *(const f32x4*)(W + (size_t)k * 9216); a0 += sv[k] * w; a1 += sv[1024 + k] * w; a2 += sv[2048 + k] * w; }
        ((LAS f32x4*)(red + (kg * 3 + 0) * 64))[cq] = a0; ((LAS f32x4*)(red + (kg * 3 + 1) * 64))[cq] = a1; ((LAS f32x4*)(red + (kg * 3 + 2) * 64))[cq] = a2;
        __syncthreads();
        if (tid < 192) { const int i = tid >> 6, c = tid & 63; float s = 0.f;
            for (int g = 0; g < 32; ++g) s += red[(g * 3 + i) * 64 + c];
            modv[(size_t)(l * 3 + i) * 9216 + n0 + c] = s + p.in[5][l * 9216 + n0 + c]; }
        __syncthreads();
    }
}
__device__ __forceinline__ void sincos_cw(float x, float& sn, float& cs) {
    const float n = rintf(x * 0.6366197723675814f);
    float r = fmaf(-n, 1.5703125f, x); r = fmaf(-n, 4.837512969970703125e-4f, r); r = fmaf(-n, 7.54978995489188216e-8f, r);
    const float z = r * r;
    const float s = r + r * z * (-1.6666654611e-1f + z * (8.3321608736e-3f + z * (-1.9515295891e-4f)));
    const float c = 1.f - 0.5f * z + z * z * (4.166664568298827e-2f + z * (-1.388731625493765e-3f + z * 2.443315711809948e-5f));
    const int q = ((int)n) & 3;
    sn = (q == 0) ? s : (q == 1) ? c : (q == 2) ? -s : -c;
    cs = (q == 0) ? c : (q == 1) ? -s : (q == 2) ? -c : s;
}
__device__ __forceinline__ void phase_tables(const Ctx cx, const Params& p) {
    const int gt = cx.bid * NTHR + cx.tid, nth = cx.nb * NTHR;
    float* rope = (float*)(p.ws + WS_ROPE);
    for (int i = gt; i < 5120; i += nth) { const bool isrow = i < 4096; const int j = isrow ? i : i - 4096; const int pos = j >> 4, f = j & 15;
        const float inv = exp2f(-(float)f * (13.287712379549449f / 16.f)); const float ang = (float)pos * inv; float c, s; sincos_cw(ang, s, c);
        if (isrow) { rope[j] = c; rope[4096 + j] = s; } else { rope[8192 + j] = c; rope[9216 + j] = s; } }
    for (int i = gt; i < 8192; i += nth) {
        const int l = i >> 11, r = i & 2047, dir = r >> 10, g = (r >> 6) & 15, pp = r & 63;
        const float a_re = fminf(p.in[15][i], -1e-4f), a_im = p.in[16][i]; const float dt = expf(p.in[17][(l * 2 + dir) * 16 + g]);
        const float mag = expf(dt * a_re); float sn_, cs_; sincos_cw(dt * a_im, sn_, cs_); const float abr = mag * cs_, abi = mag * sn_;
        float pr = abr, pi = abi;
#pragma unroll
        for (int q = 0; q < 6; ++q) { const float nr2 = pr * pr - pi * pi, ni2 = 2.f * pr * pi; pr = nr2; pi = ni2; }
        const float den = a_re * a_re + a_im * a_im, nr = abr - 1.f; const float f_re = (nr * a_re + abi * a_im) / den, f_im = (abi * a_re - nr * a_im) / den;
        unsigned char* base = p.ws + WS_S5T + (size_t)l * S5T_LAYER;
        ((f32x2*)base)[r] = (f32x2){abr, abi}; ((f32x2*)(base + S5T_ABL))[r] = (f32x2){pr, pi};
        const float* br = p.in[18] + ((size_t)(l * 16 + g) * 64 + pp) * 16; const float* bi = p.in[19] + ((size_t)(l * 16 + g) * 64 + pp) * 16;
        f32x4 brv[4], biv[4];
#pragma unroll
        for (int c = 0; c < 4; ++c) { brv[c] = ((const f32x4*)br)[c]; biv[c] = ((const f32x4*)bi)[c]; }
        float cre[16], cim[16];
#pragma unroll
        for (int co = 0; co < 16; ++co) { const size_t ci = ((size_t)((l * 2 + dir) * 16 + g) * 16 + co) * 64 + pp; cre[co] = p.in[20][ci]; cim[co] = p.in[21][ci]; }
        asm volatile("" ::: "memory");
        float bre[16], bim[16];
#pragma unroll
        for (int c = 0; c < 4; ++c)
#pragma unroll
            for (int e = 0; e < 4; ++e) { bre[4 * c + e] = f_re * brv[c][e] - f_im * biv[c][e]; bim[4 * c + e] = f_re * biv[c][e] + f_im * brv[c][e]; }
        const int dg = r >> 6;
        u32x4* rowre = (u32x4*)(base + S5T_BB + ((size_t)dg * 128 + 2 * pp) * 32); u32x4* rowim = (u32x4*)(base + S5T_BB + ((size_t)dg * 128 + 2 * pp + 1) * 32);
        rowre[0] = pack8(bre); rowre[1] = pack8(bre + 8); rowim[0] = pack8(bim); rowim[1] = pack8(bim + 8);
        bf16_t* cc = (bf16_t*)(base + S5T_CC) + (size_t)dg * 16 * 128;
#pragma unroll
        for (int co = 0; co < 16; ++co) ((unsigned*)(cc + co * 128))[pp] = pk2(cre[co], -cim[co]);
    }
}
__device__ __forceinline__ void transpose_item(const float* W, int K, int N, bf16_t* WT, int mode, LAS float* scr, int item, int lane) {
    const int nblk = N / 32, kb = item / nblk, nb = item % nblk, k0 = 64 * kb, n0 = 32 * nb;
    int d0 = n0; if (mode) { const int half = N >> 1; const int nn = n0 < half ? n0 : n0 - half; d0 = (nn >> 7) * 256 + (nn & 127) + (n0 < half ? 0 : 128); }
#pragma unroll 8
    for (int i = 0; i < 32; ++i) { const int kk = 2 * i + (lane >> 5); scr[kk * 33 + (lane & 31)] = W[(size_t)(k0 + kk) * N + n0 + (lane & 31)]; }
    asm volatile("s_waitcnt lgkmcnt(0)" ::: "memory");
    const int c = lane & 7;
#pragma unroll
    for (int j = 0; j < 4; ++j) { const int n = (lane >> 3) + 8 * j; const LAS float* s = scr + (8 * c) * 33 + n;
        u32x4 o; o.x = pk2(s[0 * 33], s[1 * 33]); o.y = pk2(s[2 * 33], s[3 * 33]); o.z = pk2(s[4 * 33], s[5 * 33]); o.w = pk2(s[6 * 33], s[7 * 33]);
        *(u32x4*)(WT + (size_t)(d0 + n) * K + k0 + 8 * c) = o; }
    asm volatile("s_waitcnt lgkmcnt(0)" ::: "memory");
}
__device__ __forceinline__ void phase_conv(const Ctx cx, const Params& p, int l, LAS unsigned char* lds) {
    const int wave = cx.tid >> 6, lane = cx.tid & 63;
    LAS float* scr = (LAS float*)(lds + wave * 16384);
    const int gw = cx.bid * NWAVE + wave, NGW = cx.nb * NWAVE;
    constexpr int I1 = 16 * 176, I2 = 44 * 32, I3 = 16 * 80, I4 = 16 * 32, I7 = 4 * 16;
    constexpr int TOT = 2 * I1 + 2 * I2 + I3 + I4 + I7;
    unsigned char* wb = p.ws + ((l & 1) ? WS_WB2 : WS_WB);
    for (int it = gw; it < TOT; it += NGW) {
        int r = it;
        if (r < I1) { transpose_item(p.in[6] + (size_t)l * 1024 * 5632, 1024, 5632, (bf16_t*)(wb + WB_F1IN), 1, scr, r, lane); continue; } r -= I1;
        if (r < I2) { transpose_item(p.in[7] + (size_t)l * 2816 * 1024, 2816, 1024, (bf16_t*)(wb + WB_F1OUT), 0, scr, r, lane); continue; } r -= I2;
        if (r < I3) { transpose_item(p.in[8] + (size_t)l * 1024 * 2560, 1024, 2560, (bf16_t*)(wb + WB_WIN), 0, scr, r, lane); continue; } r -= I3;
        if (r < I4) { transpose_item(p.in[9] + (size_t)l * 1024 * 1024, 1024, 1024, (bf16_t*)(wb + WB_WOUT), 0, scr, r, lane); continue; } r -= I4;
        if (r < I1) { transpose_item(p.in[24] + (size_t)l * 1024 * 5632, 1024, 5632, (bf16_t*)(wb + WB_F2IN), 1, scr, r, lane); continue; } r -= I1;
        if (r < I2) { transpose_item(p.in[25] + (size_t)l * 2816 * 1024, 2816, 1024, (bf16_t*)(wb + WB_F2OUT), 0, scr, r, lane); continue; } r -= I2;
        transpose_item(p.in[23] + (size_t)l * 256 * 512, 256, 512, (bf16_t*)(wb + WB_GLU), 1, scr, r, lane);
    }
}
__device__ __forceinline__ void phase_norm(const Ctx cx, const float* xl, float* xc, const float* modl, int ish, int isc, bf16_t* H, const float* part, int pend_nch, int m_end) {
    const int wave = cx.tid >> 6, lane = cx.tid & 63;
    const int gw = cx.bid * NWAVE + wave, NGW = cx.nb * NWAVE;
    for (int m = gw; m < m_end; m += NGW) {
        const float* xr = m < ML ? xl + (size_t)m * D : xc + (size_t)(m - ML) * D; const int mi = m < ML ? (m >> 14) : 2;
        const f32x4* sh = (const f32x4*)(modl + mi * 9216 + ish * 1024); const f32x4* sc = (const f32x4*)(modl + mi * 9216 + isc * 1024);
        f32x4 v[4], scv[4], shv[4]; float s = 0.f;
#pragma unroll
        for (int j = 0; j < 4; ++j) { v[j] = ((const f32x4*)xr)[lane + 64 * j]; scv[j] = sc[lane + 64 * j]; shv[j] = sh[lane + 64 * j]; }
        if (m >= ML && pend_nch > 0) {
            for (int ch = 0; ch < pend_nch; ++ch) { const f32x4* pr = (const f32x4*)(part + ((size_t)ch * 512 + (m - ML)) * 1024);
#pragma unroll
                for (int j = 0; j < 4; ++j) v[j] += pr[lane + 64 * j]; }
#pragma unroll
            for (int j = 0; j < 4; ++j) ((f32x4*)(xc + (size_t)(m - ML) * D))[lane + 64 * j] = v[j];
        }
#pragma unroll
        for (int j = 0; j < 4; ++j) s += (v[j].x * v[j].x + v[j].y * v[j].y) + (v[j].z * v[j].z + v[j].w * v[j].w);
        const float r = 1.f / sqrtf(wave_sum(s) * (1.f / D) + 1e-6f);
        u32x2* o8 = (u32x2*)(H + (size_t)m * D);
#pragma unroll
        for (int j = 0; j < 4; ++j) { const f32x4 a = scv[j], b = shv[j]; const f32x4 o = v[j] * r * (a + 1.f) + b;
            o8[lane + 64 * j] = (u32x2){pk2(o.x, o.y), pk2(o.z, o.w)}; }
    }
}
constexpr int NM_KL = 0, NM_KC = 56320, NM_VL = 76800, NM_VC = 121856, NM_BIAS = 138240, NA_LAT_ITEMS = 1024, NA_ITEMS = NA_LAT_ITEMS + 16;
__device__ __forceinline__ void na_item(const Ctx cx, const Params& p, int l, int item, LAS unsigned char* lds, const int stage_only = 0) {
    const int tid = cx.tid, wave = tid >> 6, lane = tid & 63, fr = lane & 15, fq = lane >> 4;
    const bf16_t* proj = (const bf16_t*)(p.ws + WS_HID);
    bf16_t* Y = (bf16_t*)(p.ws + WS_Y);
    const bool lat = item < NA_LAT_ITEMS;
    int b, h, rq = 0;
    if (lat) { b = item >> 9; h = (item >> 6) & 7; rq = item & 63; } else { const int j = item - NA_LAT_ITEMS; b = j >> 3; h = j & 7; }
    const int r0 = 4 * rq; const int rs0 = min(max(r0 - 4, 0), 248), rsl = min(max(r0 - 1, 0), 248);
    const int nkl = lat ? (rsl + 8 - rs0) * 64 : 0;
    const float* kgain = p.in[11] + l * 32; const float* qgain = p.in[10] + l * 32;
    { u32x4 kreg[2][4], vreg[2][4];
#pragma unroll
      for (int rr = 0; rr < 2; ++rr) { const int i = tid + NTHR * rr;
          if (i < nkl + 256) { const size_t row = i < nkl ? (size_t)b * SEQ + rs0 * 64 + i : (size_t)ML + b * CTXL + (i - nkl);
              const u32x4* ks = (const u32x4*)(proj + row * INW + C_KA + h * 32); const u32x4* vs = (const u32x4*)(proj + row * INW + C_VA + h * 32);
#pragma unroll
              for (int c = 0; c < 4; ++c) { kreg[rr][c] = ks[c]; vreg[rr][c] = vs[c]; } } }
      if (tid < 465) ((LAS float*)(lds + NM_BIAS))[tid] = 1.4426950408889634f * p.in[12][(size_t)(l * 8 + h) * 465 + tid];
#pragma unroll
      for (int rr = 0; rr < 2; ++rr) { const int i = tid + NTHR * rr;
          if (i < nkl + 256) {
              LAS unsigned char *dk, *dv;
              if (i < nkl) { dk = lds + NM_KL + i * 80; dv = lds + NM_VL + i * 64; }
              else { const int c = i - nkl; dk = lds + NM_KC + c * 80; dv = lds + NM_VC + c * 64; }
              float kf[32]; float ss = 0.f;
#pragma unroll
              for (int c = 0; c < 4; ++c) { unpack8(kreg[rr][c], kf + 8 * c); }
#pragma unroll
              for (int d = 0; d < 32; ++d) ss += kf[d] * kf[d];
              const float rn = 1.f / sqrtf(ss * (1.f / 32.f) + 1e-6f);
#pragma unroll
              for (int d = 0; d < 32; ++d) kf[d] = kf[d] * rn * kgain[d];
#pragma unroll
              for (int c = 0; c < 4; ++c) { *(LAS u32x4*)(dk + 16 * c) = pack8(kf + 8 * c); *(LAS u32x4*)(dv + 16 * c) = vreg[rr][c]; } } } }
    __syncthreads();
    const LAS float* bias = (const LAS float*)(lds + NM_BIAS);
    if (!stage_only) {
        int r_[2], wq_[2], rs_[2], cs_[2], c0_[2]; size_t qrow_[2]; bf16x8 qf_[2]; int co_[2][2][4]; float okm_[2][2][4];
        float mrun[2], lsum[2]; f32x4 o0[2], o1[2];
#pragma unroll
        for (int t = 0; t < 2; ++t) { const int qt = wave + 8 * t;
            const int r = r0 + (qt >> 2), w0 = 16 * (qt & 3), wq = w0 + fr;
            const size_t qrow = lat ? (size_t)b * SEQ + r * 64 + wq : (size_t)ML + b * CTXL + qt * 16 + fr;
            float q[8]; unpack8(*(const u32x4*)(proj + qrow * INW + C_QA + h * 32 + 8 * fq), q); float ss = 0.f;
#pragma unroll
            for (int e = 0; e < 8; ++e) ss += q[e] * q[e];
            ss = rows_sum(ss);
            const float rn = (0.17677669529663687f * 1.4426950408889634f) / sqrtf(ss * (1.f / 32.f) + 1e-6f);
#pragma unroll
            for (int e = 0; e < 8; ++e) q[e] = q[e] * rn * qgain[8 * fq + e];
            qf_[t] = __builtin_bit_cast(bf16x8, pack8(q));
            r_[t] = r; wq_[t] = wq; qrow_[t] = qrow; rs_[t] = min(max(r - 4, 0), 248); cs_[t] = min(max(wq - 8, 0), 48); c0_[t] = min(max(w0 - 8, 0), 32);
            mrun[t] = -1e30f; lsum[t] = 0.f; o0[t] = (f32x4){0.f, 0.f, 0.f, 0.f}; o1[t] = o0[t];
#pragma unroll
            for (int cbi = 0; cbi < 2; ++cbi)
#pragma unroll
                for (int e = 0; e < 4; ++e) { const int kc = c0_[t] + 16 * cbi + 4 * fq + e; co_[t][cbi][e] = min(max(kc - wq + 15, 0), 30); okm_[t][cbi][e] = ((kc >= cs_[t]) && (kc < cs_[t] + 16)) ? 0.f : -1e30f; } }
        const int ngrp = lat ? 8 : 4;
#pragma unroll 1
        for (int g = 0; g < ngrp; ++g) {
            f32x4 s[2][4]; int vk[2][4];
            const LAS unsigned char* vb;
            if (g < 4) { vb = lds + NM_VC;
#pragma unroll
                for (int i = 0; i < 4; ++i) { const int kt = 4 * g + i;
                    const bf16x8 a = *(const LAS bf16x8*)(lds + NM_KC + (16 * kt + fr) * 80 + 16 * fq);
#pragma unroll
                    for (int t = 0; t < 2; ++t) { vk[t][i] = 16 * kt; s[t][i] = MFMA16(a, qf_[t], ((f32x4){0.f, 0.f, 0.f, 0.f})); } }
            } else { vb = lds + NM_VL;
#pragma unroll
                for (int t = 0; t < 2; ++t)
#pragma unroll
                    for (int i = 0; i < 4; ++i) { const int lt = 4 * (g - 4) + i; const int kri = lt >> 1, cb = c0_[t] + 16 * (lt & 1); const int kr = rs_[t] + kri; const int base = (kr - rs0) * 64 + cb; vk[t][i] = base;
                        const bf16x8 a = *(const LAS bf16x8*)(lds + NM_KL + (base + fr) * 80 + 16 * fq); f32x4 sv = MFMA16(a, qf_[t], ((f32x4){0.f, 0.f, 0.f, 0.f}));
                        const LAS float* brow = bias + (kr - r_[t] + 7) * 31;
                        float bv[4];
#pragma unroll
                        for (int e = 0; e < 4; ++e) bv[e] = brow[co_[t][lt & 1][e]];
#pragma unroll
                        for (int e = 0; e < 4; ++e) asm volatile("" : "+v"(bv[e]));
#pragma unroll
                        for (int e = 0; e < 4; ++e) sv[e] = (okm_[t][lt & 1][e] < 0.f) ? -1e30f : sv[e] + bv[e];
                        s[t][i] = sv; }
            }
            float gm[2];
#pragma unroll
            for (int t = 0; t < 2; ++t) { float m_ = -1e30f;
#pragma unroll
                for (int i = 0; i < 4; ++i) m_ = fmaxf(m_, fmaxf(fmaxf(s[t][i][0], s[t][i][1]), fmaxf(s[t][i][2], s[t][i][3])));
                gm[t] = m_; }
#pragma unroll
            for (int t = 0; t < 2; ++t) gm[t] = rows_max(gm[t]);
            float pe[2][16];
#pragma unroll
            for (int t = 0; t < 2; ++t) { const float mn = fmaxf(mrun[t], gm[t]); const float alpha = __builtin_amdgcn_exp2f(mrun[t] - mn); mrun[t] = mn; lsum[t] *= alpha; o0[t] = o0[t] * alpha; o1[t] = o1[t] * alpha;
#pragma unroll
                for (int i = 0; i < 4; ++i)
#pragma unroll
                    for (int e = 0; e < 4; ++e) { const float pv = __builtin_amdgcn_exp2f(s[t][i][e] - mn); pe[t][4 * i + e] = pv; lsum[t] += pv; } }
#pragma unroll
            for (int pr = 0; pr < 2; ++pr)
#pragma unroll
                for (int t = 0; t < 2; ++t) {
                    const bf16x8 pb = __builtin_bit_cast(bf16x8, pack8(pe[t] + 8 * pr));
                    const int kA = vk[t][2 * pr] + 4 * fq, kB = vk[t][2 * pr + 1] + 4 * fq;
                    o0[t] = MFMA16(tr8ab(vb, 64, kA, kB, 0, fr), pb, o0[t]); o1[t] = MFMA16(tr8ab(vb, 64, kA, kB, 16, fr), pb, o1[t]);
                }
        }
#pragma unroll
        for (int t = 0; t < 2; ++t) {
            const float ls = rows_sum(lsum[t]);
            const float inv = 1.f / ls;
            *(u32x2*)(Y + qrow_[t] * D + h * 32 + 4 * fq) = (u32x2){pk2(o0[t][0] * inv, o0[t][1] * inv), pk2(o0[t][2] * inv, o0[t][3] * inv)};
            *(u32x2*)(Y + qrow_[t] * D + h * 32 + 16 + 4 * fq) = (u32x2){pk2(o1[t][0] * inv, o1[t][1] * inv), pk2(o1[t][2] * inv, o1[t][3] * inv)};
        }
    }
    __syncthreads();
}
__device__ __forceinline__ size_t ret_row(int b, int sc, int j) { return sc < 2 ? (size_t)ML + b * CTXL + sc * 128 + j : (size_t)b * SEQ + (sc - 2) * 128 + j; }
__device__ __forceinline__ void rope16(const bf16_t* src, int q, bool lat, int trow, int tcol, const float* rope, float* o1, float* o2) {
    float z1[8], z2[8]; unpack8(*(const u32x4*)(src + 8 * q), z1); unpack8(*(const u32x4*)(src + 32 + 8 * q), z2);
    if (lat) {
        const float* cp = q < 2 ? rope + trow * 16 + 8 * q : rope + 8192 + tcol * 16 + 8 * (q - 2);
        const float* sp = q < 2 ? rope + 4096 + trow * 16 + 8 * q : rope + 9216 + tcol * 16 + 8 * (q - 2);
#pragma unroll
        for (int e = 0; e < 8; ++e) { const float c = cp[e], s = sp[e]; o1[e] = z1[e] * c - z2[e] * s; o2[e] = z1[e] * s + z2[e] * c; }
    } else {
#pragma unroll
        for (int e = 0; e < 8; ++e) { o1[e] = z1[e]; o2[e] = z2[e]; }
    }
}
__device__ __forceinline__ void rope_tab_load(const float* rope, int q, int trow, int tcol, f32x4* tab) {
    const float* cp = q < 2 ? rope + trow * 16 + 8 * q : rope + 8192 + tcol * 16 + 8 * (q - 2);
    const float* sp = q < 2 ? rope + 4096 + trow * 16 + 8 * q : rope + 9216 + tcol * 16 + 8 * (q - 2);
    tab[0] = ((const f32x4*)cp)[0]; tab[1] = ((const f32x4*)cp)[1]; tab[2] = ((const f32x4*)sp)[0]; tab[3] = ((const f32x4*)sp)[1];
}
__device__ __forceinline__ void rope_apply(const u32x4 lo, const u32x4 hi, bool lat, const f32x4* tab, float* o1, float* o2) {
    float z1[8], z2[8]; unpack8(lo, z1); unpack8(hi, z2);
    if (lat) {
#pragma unroll
        for (int e = 0; e < 8; ++e) { const float c = tab[e >> 2][e & 3], sn = tab[2 + (e >> 2)][e & 3]; o1[e] = z1[e] * c - z2[e] * sn; o2[e] = z1[e] * sn + z2[e] * c; }
    } else {
#pragma unroll
        for (int e = 0; e < 8; ++e) { o1[e] = z1[e]; o2[e] = z2[e]; }
    }
}
__device__ __forceinline__ void stage_v(const bf16_t* proj, int b, int h, int sc, LAS unsigned char* vrow, int tid) {
    const int j = tid >> 2, q = tid & 3;
    const u32x4* vs = (const u32x4*)(proj + ret_row(b, sc, j) * INW + C_VB + h * 128 + 32 * q);
#pragma unroll
    for (int c = 0; c < 4; ++c) *(LAS u32x4*)(vrow + j * 288 + 64 * q + 16 * c) = vs[c];
}
constexpr int R1_V = 0, R1_KF = 36864, R1_KB = 57344, RET_ITEMS = NB * 4 * 130;
__device__ __forceinline__ void ret_kv_item(const Ctx cx, const Params& p, int l, int item, LAS unsigned char* lds) {
    const int tid = cx.tid, wave = tid >> 6, lane = tid & 63, fr = lane & 15, fq = lane >> 4;
    const bf16_t* proj = (const bf16_t*)(p.ws + WS_HID); const float* rope = (const float*)(p.ws + WS_ROPE);
    const int b = item / 520, h = (item / 130) & 3, sc = item % 130; const bool lat = sc >= 2;
    const float lgf = log_sigmoid(p.in[13][(l * 2 + 0) * 4 + h]), lgb = log_sigmoid(p.in[13][(l * 2 + 1) * 4 + h]);
    {
      const int j = tid >> 2, q = tid & 3; const int t = (sc - 2) * 128 + j; const size_t row = ret_row(b, sc, j);
      const bf16_t* ksrc = proj + row * INW + C_KB + h * 64;
      const u32x4 k0 = *(const u32x4*)(ksrc + 8 * q), k1 = *(const u32x4*)(ksrc + 32 + 8 * q);
      const u32x4* vs = (const u32x4*)(proj + row * INW + C_VB + h * 128 + 32 * q);
      u32x4 vv[4];
#pragma unroll
      for (int c = 0; c < 4; ++c) vv[c] = vs[c];
      f32x4 tab[4];
      if (lat) rope_tab_load(rope, q, t >> 6, t & 63, tab);
      float o1[8], o2[8]; rope_apply(k0, k1, lat, tab, o1, o2);
      const float wf = 0.125f * __builtin_amdgcn_exp2f(1.4426950408889634f * lgf * (float)(127 - j)), wb = 0.125f * __builtin_amdgcn_exp2f(1.4426950408889634f * lgb * (float)j);
      float t1[8], t2[8];
#pragma unroll
      for (int e = 0; e < 8; ++e) { t1[e] = o1[e] * wf; t2[e] = o2[e] * wf; }
      *(LAS u32x4*)(lds + R1_KF + j * 160 + 16 * q) = pack8(t1); *(LAS u32x4*)(lds + R1_KF + j * 160 + 64 + 16 * q) = pack8(t2);
#pragma unroll
      for (int e = 0; e < 8; ++e) { t1[e] = o1[e] * wb; t2[e] = o2[e] * wb; }
      *(LAS u32x4*)(lds + R1_KB + j * 160 + 16 * q) = pack8(t1); *(LAS u32x4*)(lds + R1_KB + j * 160 + 64 + 16 * q) = pack8(t2);
#pragma unroll
      for (int c = 0; c < 4; ++c) *(LAS u32x4*)(lds + R1_V + j * 288 + 64 * q + 16 * c) = vv[c]; }
    __syncthreads();
    bf16x8 a[4];
#pragma unroll
    for (int ks = 0; ks < 4; ++ks) a[ks] = tr8(lds + R1_V, 288, 32 * ks + 8 * fq, 16 * wave, fr);
    float* kvf = (float*)(p.ws + WS_KV) + ((size_t)((b * 4 + h) * 2 + 0) * 130 + sc) * 8192;
    float* kvb = (float*)(p.ws + WS_KV) + ((size_t)((b * 4 + h) * 2 + 1) * 130 + sc) * 8192;
#pragma unroll
    for (int nt = 0; nt < 4; ++nt) { f32x4 cf = {0.f, 0.f, 0.f, 0.f}, cb = cf;
#pragma unroll
        for (int ks = 0; ks < 4; ++ks) { const bf16x8 bf = tr8(lds + R1_KF, 160, 32 * ks + 8 * fq, 16 * nt, fr); const bf16x8 bb = tr8(lds + R1_KB, 160, 32 * ks + 8 * fq, 16 * nt, fr);
            cf = MFMA16(bf, a[ks], cf); cb = MFMA16(bb, a[ks], cb); }
        *(f32x4*)(kvf + (16 * wave + fr) * 64 + 16 * nt + 4 * fq) = cf; *(f32x4*)(kvb + (16 * wave + fr) * 64 + 16 * nt + 4 * fq) = cb; }
    __syncthreads();
}
__device__ __forceinline__ void phase_scans(const Ctx cx, const Params& p, int l) {
    const int tid = cx.tid;
    for (int gt = cx.bid * NTHR + tid; gt < 16 * 8192; gt += cx.nb * NTHR) {
        const int idx = gt & 8191, seq = gt >> 13, dir = seq & 1, h = (seq >> 1) & 3;
        const float gch = expf(128.f * log_sigmoid(p.in[13][(l * 2 + dir) * 4 + h]));
        const float* base = (const float*)(p.ws + WS_KV) + (size_t)seq * 130 * 8192 + idx;
        bf16_t* sb16 = (bf16_t*)(p.ws + WS_SB16) + (size_t)seq * 130 * 8192 + idx;
        float S = 0.f;
        for (int k0 = 0; k0 < 130; k0 += 26) { float t[26];
#pragma unroll
            for (int k = 0; k < 26; ++k) { const int kk = k0 + k; const int sc = dir == 0 ? kk : (kk < 2 ? 1 - kk : 131 - kk); t[k] = base[(size_t)sc * 8192]; }
            asm volatile("" ::: "memory");
#pragma unroll
            for (int k = 0; k < 26; ++k) { const int kk = k0 + k; const int sc = dir == 0 ? kk : (kk < 2 ? 1 - kk : 131 - kk); sb16[(size_t)sc * 8192] = (bf16_t)f2bf(S); S = gch * S + t[k]; } }
    }
    if (tid < 64) for (int w = cx.bid; w < 64; w += cx.nb) {
        const int e = w * 64 + tid; const int pp = e & 63, seq = e >> 6, dir = seq & 1, g = (seq >> 1) & 15;
        const f32x2 al = ((const f32x2*)(p.ws + WS_S5T + (size_t)l * S5T_LAYER + S5T_ABL))[(dir * 16 + g) * 64 + pp];
        f32x2* base = (f32x2*)(p.ws + WS_S5E) + (size_t)seq * 260 * 64 + pp;
        float xr = 0.f, xi = 0.f;
        for (int k0 = 0; k0 < 260; k0 += 26) { f32x2 t[26];
#pragma unroll
            for (int k = 0; k < 26; ++k) { const int kk = k0 + k; const int sc = dir == 0 ? kk : (kk < 4 ? 3 - kk : 263 - kk); t[k] = base[(size_t)sc * 64]; }
            asm volatile("" ::: "memory");
#pragma unroll
            for (int k = 0; k < 26; ++k) { const int kk = k0 + k; const int sc = dir == 0 ? kk : (kk < 4 ? 3 - kk : 263 - kk); base[(size_t)sc * 64] = (f32x2){xr, xi};
                const float nr = al.x * xr - al.y * xi + t[k].x, ni = al.x * xi + al.y * xr + t[k].y; xr = nr; xi = ni; } }
    }
}
constexpr int R2_Q = 0, R2_K = 18432, R2_V = 36864, R2_P = 73728, R2_SF = 108544, R2_SB = 126976;
__device__ __forceinline__ void ret_out_item(const Ctx cx, const Params& p, int l, int item, LAS unsigned char* lds) {
    const int tid = cx.tid, wave = tid >> 6, lane = tid & 63, fr = lane & 15, fq = lane >> 4;
    const bf16_t* proj = (const bf16_t*)(p.ws + WS_HID); const float* rope = (const float*)(p.ws + WS_ROPE); bf16_t* Y = (bf16_t*)(p.ws + WS_Y);
    const int b = item / 520, h = (item / 130) & 3, sc = item % 130; const bool lat = sc >= 2;
    const float l2f = 1.4426950408889634f * log_sigmoid(p.in[13][(l * 2 + 0) * 4 + h]), l2b = 1.4426950408889634f * log_sigmoid(p.in[13][(l * 2 + 1) * 4 + h]);
    {
      const int j = tid >> 2, q = tid & 3; const int t = (sc - 2) * 128 + j; const size_t row = ret_row(b, sc, j);
      const bf16_t* qsrc = proj + row * INW + C_QB + h * 64; const bf16_t* ksrc = proj + row * INW + C_KB + h * 64;
      const u32x4 q0 = *(const u32x4*)(qsrc + 8 * q), q1 = *(const u32x4*)(qsrc + 32 + 8 * q), k0 = *(const u32x4*)(ksrc + 8 * q), k1 = *(const u32x4*)(ksrc + 32 + 8 * q);
      const u32x4* vs = (const u32x4*)(proj + row * INW + C_VB + h * 128 + 32 * q);
      u32x4 vv[4];
#pragma unroll
      for (int c = 0; c < 4; ++c) vv[c] = vs[c];
      const int d0 = q * 16;
      const u32x4* sf = (const u32x4*)((const bf16_t*)(p.ws + WS_SB16) + ((size_t)((b * 4 + h) * 2 + 0) * 130 + sc) * 8192 + j * 64 + d0);
      const u32x4* sb = (const u32x4*)((const bf16_t*)(p.ws + WS_SB16) + ((size_t)((b * 4 + h) * 2 + 1) * 130 + sc) * 8192 + j * 64 + d0);
      const u32x4 sf0 = sf[0], sf1 = sf[1], sb0 = sb[0], sb1 = sb[1];
      f32x4 tab[4];
      if (lat) rope_tab_load(rope, q, t >> 6, t & 63, tab);
      float o1[8], o2[8];
      rope_apply(q0, q1, lat, tab, o1, o2);
      *(LAS u32x4*)(lds + R2_Q + j * 144 + 16 * q) = pack8(o1); *(LAS u32x4*)(lds + R2_Q + j * 144 + 64 + 16 * q) = pack8(o2);
      rope_apply(k0, k1, lat, tab, o1, o2);
#pragma unroll
      for (int e = 0; e < 8; ++e) { o1[e] *= 0.125f; o2[e] *= 0.125f; }
      *(LAS u32x4*)(lds + R2_K + j * 144 + 16 * q) = pack8(o1); *(LAS u32x4*)(lds + R2_K + j * 144 + 64 + 16 * q) = pack8(o2);
#pragma unroll
      for (int c = 0; c < 4; ++c) *(LAS u32x4*)(lds + R2_V + j * 288 + 64 * q + 16 * c) = vv[c];
      *(LAS u32x4*)(lds + R2_SF + j * 144 + d0 * 2) = sf0; *(LAS u32x4*)(lds + R2_SF + j * 144 + d0 * 2 + 16) = sf1;
      *(LAS u32x4*)(lds + R2_SB + j * 144 + d0 * 2) = sb0; *(LAS u32x4*)(lds + R2_SB + j * 144 + d0 * 2 + 16) = sb1; }
    __syncthreads();
    bf16x8 aq[2];
#pragma unroll
    for (int ks = 0; ks < 2; ++ks) aq[ks] = *(const LAS bf16x8*)(lds + R2_Q + (16 * wave + fr) * 144 + (32 * ks + 8 * fq) * 2);
    bf16x8 pb[4];
    { const int ti_ = 16 * wave + fr; float pe[8];
#pragma unroll
      for (int nt = 0; nt < 8; ++nt) { f32x4 sv = {0.f, 0.f, 0.f, 0.f};
#pragma unroll
          for (int ks = 0; ks < 2; ++ks) { const bf16x8 bk = *(const LAS bf16x8*)(lds + R2_K + (16 * nt + fr) * 144 + (32 * ks + 8 * fq) * 2); sv = MFMA16(bk, aq[ks], sv); }
#pragma unroll
          for (int e = 0; e < 4; ++e) { const int dd = ti_ - (16 * nt + 4 * fq + e);
              const float dec = __builtin_amdgcn_exp2f(dd >= 0 ? (float)dd * l2f : (float)(-dd) * l2b);
              pe[4 * (nt & 1) + e] = sv[e] * dec; }
          if (nt & 1) pb[nt >> 1] = __builtin_bit_cast(bf16x8, pack8(pe)); } }
    f32x4 o[8];
#pragma unroll
    for (int vt = 0; vt < 8; ++vt) { f32x4 c = {0.f, 0.f, 0.f, 0.f};
#pragma unroll
        for (int pr = 0; pr < 4; ++pr) { const bf16x8 bv = tr8ab(lds + R2_V, 288, 32 * pr + 4 * fq, 32 * pr + 16 + 4 * fq, 16 * vt, fr); c = MFMA16(bv, pb[pr], c); }
        o[vt] = c; }
    const int ti = 16 * wave + fr;
    const size_t row = ret_row(b, sc, ti);
    u32x2 gt[8];
#pragma unroll
    for (int vt = 0; vt < 8; ++vt) gt[vt] = *(const u32x2*)(proj + row * INW + C_GB + h * 128 + 16 * vt + 4 * fq);
    const float wfi = exp2f((float)(ti + 1) * l2f), wbi = exp2f((float)(128 - ti) * l2b);
#pragma unroll
    for (int vt = 0; vt < 8; ++vt) { f32x4 cf = {0.f, 0.f, 0.f, 0.f}, cb = cf;
#pragma unroll
        for (int ks = 0; ks < 2; ++ks) { const bf16x8 bf = *(const LAS bf16x8*)(lds + R2_SF + (16 * vt + fr) * 144 + (32 * ks + 8 * fq) * 2); const bf16x8 bb = *(const LAS bf16x8*)(lds + R2_SB + (16 * vt + fr) * 144 + (32 * ks + 8 * fq) * 2);
            cf = MFMA16(bf, aq[ks], cf); cb = MFMA16(bb, aq[ks], cb); }
        o[vt] = o[vt] + wfi * cf + wbi * cb; }
    const float* gn = p.in[14] + l * 512 + h * 128;
    float sm = 0.f;
#pragma unroll
    for (int vt = 0; vt < 8; ++vt) sm += (o[vt][0] + o[vt][1]) + (o[vt][2] + o[vt][3]);
    sm = rows_sum(sm);
    const float mu = sm * (1.f / 128.f); float qv = 0.f;
#pragma unroll
    for (int vt = 0; vt < 8; ++vt)
#pragma unroll
        for (int e = 0; e < 4; ++e) { const float dlt = o[vt][e] - mu; qv += dlt * dlt; }
    qv = rows_sum(qv);
    const float rstd = 1.f / sqrtf(qv * (1.f / 128.f) + 1e-6f);
#pragma unroll
    for (int vt = 0; vt < 8; ++vt) { const f32x4 gv = *(const f32x4*)(gn + 16 * vt + 4 * fq);
        const float g0 = bflo(gt[vt].x), g1 = bfhi(gt[vt].x), g2 = bflo(gt[vt].y), g3 = bfhi(gt[vt].y);
        const float y0 = g0 * pg8::sigm(g0) * ((o[vt][0] - mu) * rstd * gv.x), y1 = g1 * pg8::sigm(g1) * ((o[vt][1] - mu) * rstd * gv.y);
        const float y2 = g2 * pg8::sigm(g2) * ((o[vt][2] - mu) * rstd * gv.z), y3 = g3 * pg8::sigm(g3) * ((o[vt][3] - mu) * rstd * gv.w);
        *(u32x2*)(Y + row * D + 256 + h * 128 + 16 * vt + 4 * fq) = (u32x2){pk2(y0, y1), pk2(y2, y3)}; }
    __syncthreads();
}
constexpr int S5_U = 0, S5_W = 17408, S5_WSTRIDE = 12800, S5_BU = 0, S5_X = 8448, S5_ITEMS = NB * 260 * 2;
__device__ __forceinline__ size_t s5_row(int b, int c64, int t) { return c64 < 4 ? (size_t)ML + b * CTXL + c64 * 64 + t : (size_t)b * SEQ + (c64 - 4) * 64 + t; }
__device__ __forceinline__ float gelu_tanh(float x) { const float u = 0.7978845608028654f * (x + 0.044715f * x * x * x); const float t = 1.f - 2.f / (1.f + __expf(2.f * u)); return 0.5f * x * (1.f + t); }
template <int PASS> __device__ __forceinline__ void s5_item(const Ctx cx, const Params& p, int l, int item, LAS unsigned char* lds) {
    const int tid = cx.tid, wave = tid >> 6, lane = tid & 63, fr = lane & 15, fq = lane >> 4;
    const bf16_t* proj = (const bf16_t*)(p.ws + WS_HID);
    const int go = item & 1, c64 = (item >> 1) % 260, b = (item >> 1) / 260;
    const int grp = go * 8 + wave;
    if (PASS == 1) {
#pragma unroll
        for (int rep = 0; rep < 2; ++rep) { const int ci = tid + NTHR * rep; const int t = ci >> 4, c8 = ci & 15;
            *(LAS u32x4*)(lds + S5_U + t * 272 + c8 * 16) = *(const u32x4*)(proj + s5_row(b, c64, t) * INW + C_UB + go * 128 + 8 * c8); }
        __syncthreads();
    }
    LAS unsigned char* W = lds + S5_W + wave * S5_WSTRIDE;
    LAS float* BU = (LAS float*)(W + S5_BU); LAS unsigned char* X = W + S5_X;
    const unsigned char* tb = p.ws + WS_S5T + (size_t)l * S5T_LAYER;
    f32x2 ab2_[2], e2_[2]; bf16x8 cf2_[2][4];
    if (PASS == 2) {
#pragma unroll
        for (int dir = 0; dir < 2; ++dir) {
            ab2_[dir] = ((const f32x2*)tb)[(dir * 16 + grp) * 64 + lane];
            e2_[dir] = *((const f32x2*)(p.ws + WS_S5E) + ((size_t)((b * 16 + grp) * 2 + dir) * 260 + c64) * 64 + lane);
#pragma unroll
            for (int ks = 0; ks < 4; ++ks) cf2_[dir][ks] = __builtin_bit_cast(bf16x8, *(const u32x4*)(tb + S5T_CC + (((size_t)(dir * 16 + grp) * 16 + fr) * 128 + 32 * ks + 8 * fq) * 2));
        }
    }
    f32x4 yacc[4];
#pragma unroll
    for (int i = 0; i < 4; ++i) yacc[i] = (f32x4){0.f, 0.f, 0.f, 0.f};
#pragma unroll
    for (int dir = 0; dir < 2; ++dir) {
        asm volatile("" ::: "memory");
        const f32x2 ab = (PASS == 2) ? ab2_[dir] : ((const f32x2*)tb)[(dir * 16 + grp) * 64 + lane];
        bf16x8 bbf[8];
        if (PASS == 1) {
#pragma unroll
            for (int nt = 0; nt < 8; ++nt) { u32x4 w = {0u, 0u, 0u, 0u};
                if (fq < 2) w = *(const u32x4*)(tb + S5T_BB + (((size_t)(dir * 16 + grp) * 128 + 16 * nt + fr) * 16 + 8 * fq) * 2);
                bbf[nt] = __builtin_bit_cast(bf16x8, w); }
        }
        bf16x8 cf[4];
#pragma unroll
        for (int ks = 0; ks < 4; ++ks) cf[ks] = (PASS == 2) ? cf2_[dir][ks] : __builtin_bit_cast(bf16x8, *(const u32x4*)(tb + S5T_CC + (((size_t)(dir * 16 + grp) * 16 + fr) * 128 + 32 * ks + 8 * fq) * 2));
        float xr = 0.f, xi = 0.f;
        f32x2* E = (f32x2*)(p.ws + WS_S5E) + ((size_t)((b * 16 + grp) * 2 + dir) * 260 + c64) * 64 + lane;
        if (PASS == 2) { xr = e2_[dir].x; xi = e2_[dir].y; }
#pragma unroll
        for (int sc = 0; sc < 4; ++sc) {
            asm volatile("" ::: "memory");
            const int tix = dir ? 3 - sc : sc; const int T0 = 16 * tix;
            if (PASS == 1) {
                u32x4 aw = {0u, 0u, 0u, 0u};
                if (fq < 2) aw = *(const LAS u32x4*)(lds + S5_U + (T0 + fr) * 272 + (wave * 16 + 8 * fq) * 2);
                const bf16x8 a = __builtin_bit_cast(bf16x8, aw);
#pragma unroll
                for (int nt = 0; nt < 8; ++nt) { const f32x4 c = MFMA16(bbf[nt], a, ((f32x4){0.f, 0.f, 0.f, 0.f}));
                    *(LAS f32x4*)(BU + fr * 132 + 16 * nt + 4 * fq) = c; }
                asm volatile("" ::: "memory");
            }
#pragma unroll
            for (int tt = 0; tt < 16; ++tt) { const int tl = dir ? 15 - tt : tt;
                float bur = 0.f, bui = 0.f;
                if (PASS == 1) { const f32x2 bu = *(const LAS f32x2*)(BU + tl * 132 + 2 * lane); bur = bu.x; bui = bu.y; }
                const float nr = ab.x * xr - ab.y * xi + bur, ni = ab.x * xi + ab.y * xr + bui; xr = nr; xi = ni;
                *(LAS unsigned*)(X + tl * 272 + lane * 4) = pk2(xr, xi); }
            asm volatile("" ::: "memory");
#pragma unroll
            for (int ks = 0; ks < 4; ++ks) { const bf16x8 a = *(const LAS bf16x8*)(X + fr * 272 + (32 * ks + 8 * fq) * 2); yacc[tix] = MFMA16(cf[ks], a, yacc[tix]);   }
        }
        if (PASS == 1) *E = (f32x2){xr, xi};
    }
    float* s5y = (float*)(p.ws + WS_S5Y); bf16_t* G = (bf16_t*)(p.ws + WS_G);
    const f32x4 dsk4 = *(const f32x4*)(p.in[22] + l * 256 + grp * 16 + 4 * fq);
    if (PASS == 1) {
#pragma unroll
        for (int ti = 0; ti < 4; ++ti) { const int t = 16 * ti + fr; const size_t row = s5_row(b, c64, t);
            const u32x2 uu = *(const LAS u32x2*)(lds + S5_U + t * 272 + (wave * 16 + 4 * fq) * 2);
            const f32x4 u4 = {bflo(uu.x), bfhi(uu.x), bflo(uu.y), bfhi(uu.y)};
            *(f32x4*)(s5y + row * 256 + grp * 16 + 4 * fq) = yacc[ti] + dsk4 * u4; }
    } else {
        f32x4 yl[4];
#pragma unroll
        for (int ti = 0; ti < 4; ++ti) yl[ti] = *(const f32x4*)(s5y + s5_row(b, c64, 16 * ti + fr) * 256 + grp * 16 + 4 * fq);
        asm volatile("" ::: "memory");
#pragma unroll
        for (int ti = 0; ti < 4; ++ti) { const f32x4 v = yacc[ti] + yl[ti];
            *(u32x2*)(G + s5_row(b, c64, 16 * ti + fr) * 256 + grp * 16 + 4 * fq) = (u32x2){pk2(gelu_tanh(v[0]), gelu_tanh(v[1])), pk2(gelu_tanh(v[2]), gelu_tanh(v[3]))}; }
    }
    if (PASS == 1) __syncthreads();
}
#define XB_TMO      128
#define XB_XCNT(j)  (256  + 64 * (j))
#define XB_XSUB(j)  (1280 + 64 * (j))
#define XB_XGEN(j)  (2304 + 64 * (j))
#define XB_TOP      3328
#define XB_TOPGEN   3392
#define XCD_BAR_WORDS 3456
#define XB_SPIN_CAP (1u << 18)

__device__ __forceinline__ unsigned xb_ld(unsigned* p)              { return __hip_atomic_load(p, __ATOMIC_RELAXED, __HIP_MEMORY_SCOPE_AGENT); }
__device__ __forceinline__ unsigned xb_add(unsigned* p, unsigned v) { return __hip_atomic_fetch_add(p, v, __ATOMIC_RELAXED, __HIP_MEMORY_SCOPE_AGENT); }
__device__ __forceinline__ unsigned xb_xcc_id() { return (unsigned)__builtin_amdgcn_s_getreg((3 << 11) | 20) & 0xFu; }
#define XB_SPIN(cond, bar) do { unsigned _sp = 0; while (cond) { __builtin_amdgcn_s_sleep(1); \
    if ((++_sp & 255u) == 0u) { if (xb_ld(&(bar)[XB_TMO])) break; if (_sp > XB_SPIN_CAP) { atomicAdd(&(bar)[XB_TMO], 1u); break; } } } } while (0)

struct XcdBarrier {
    unsigned* bar; unsigned x;
    volatile LAS unsigned* st;
};

__device__ __forceinline__ XcdBarrier xcd_barrier_post(unsigned* bar, volatile LAS unsigned* st) {
    XcdBarrier b; b.bar = bar; b.x = xb_xcc_id(); b.st = st;
    if (threadIdx.x == 0) (void)xb_add(&bar[XB_XCNT(b.x)], 1u);
    return b;
}
__device__ __forceinline__ void xcd_barrier_complete(unsigned* bar, unsigned x, unsigned& nloc, unsigned& nx) {
    const unsigned G = gridDim.x * gridDim.y * gridDim.z;
    unsigned sum, cnt, mine, sp = 0u;
    for (;;) {
        sum = 0u; cnt = 0u; mine = 0u;
#pragma unroll
        for (unsigned j = 0; j < 16; ++j) { const unsigned c = xb_ld(&bar[XB_XCNT(j)]); sum += c; cnt += (c > 0u) ? 1u : 0u; mine = (j == x) ? c : mine; }
        if (sum == G) break;
        __builtin_amdgcn_s_sleep(1);
        if ((++sp & 255u) == 0u) { if (xb_ld(&bar[XB_TMO])) break; if (sp > XB_SPIN_CAP) { atomicAdd(&bar[XB_TMO], 1u); break; } }
    }
    nloc = mine > 0u ? mine : 1u; nx = cnt > 0u ? cnt : 1u;
}

__device__ __forceinline__ void xcd_barrier(const XcdBarrier& b) {
    asm volatile("s_waitcnt vmcnt(0)" ::: "memory");
    __syncthreads();
    if (threadIdx.x == 0) {
        unsigned* bar = b.bar;
        __builtin_amdgcn_s_waitcnt(0);
        unsigned nloc = b.st[0], nx = b.st[1];
        if (nloc == 0u) { xcd_barrier_complete(bar, b.x, nloc, nx); b.st[0] = nloc; b.st[1] = nx; }
        const unsigned old = xb_add(&bar[XB_XSUB(b.x)], 1u);
        const unsigned gen = old / nloc;
        if (old + 1u == (gen + 1u) * nloc) {
            __builtin_amdgcn_fence(__ATOMIC_RELEASE, "agent");
            asm volatile("s_waitcnt vmcnt(0)" ::: "memory");
            const unsigned og = xb_add(&bar[XB_TOP], 1u);
            const unsigned tg = og / nx;
            if (og + 1u == (tg + 1u) * nx) xb_add(&bar[XB_TOPGEN], 1u);
            else XB_SPIN(xb_ld(&bar[XB_TOPGEN]) == tg, bar);
            __builtin_amdgcn_fence(__ATOMIC_ACQUIRE, "agent");
            xb_add(&bar[XB_XGEN(b.x)], 1u);
            asm volatile("s_waitcnt vmcnt(0)" ::: "memory");
        } else {
            XB_SPIN(xb_ld(&bar[XB_XGEN(b.x)]) == gen, bar);
            __builtin_amdgcn_fence(__ATOMIC_ACQUIRE, "agent");
            asm volatile("s_waitcnt vmcnt(0)" ::: "memory");
        }
    }
    __syncthreads();
}


__global__ void __launch_bounds__(NTHR) fwd_mega(Params p_unused) {
    extern __shared__ __attribute__((aligned(16))) unsigned char lds_raw[];
    LAS unsigned char* lds = (LAS unsigned char*)lds_raw;
    cg::grid_group grid = cg::this_grid();
    volatile LAS unsigned* bst = (volatile LAS unsigned*)(lds + LDS_BYTES - 16);
    if (threadIdx.x == 0) { bst[0] = 0u; bst[1] = 0u; }
    __syncthreads();
    { const __attribute__((address_space(4))) Params* kp0 = (const __attribute__((address_space(4))) Params*)__builtin_amdgcn_kernarg_segment_ptr(); (void)xcd_barrier_post((unsigned*)(kp0->ws + WS_DIAG), bst); }
    int dup_done = 0;
#pragma unroll 1
    for (int ph = 0; ph < 1 + 13 * DEPTH; ++ph) {
        const __attribute__((address_space(4))) Params* kp = (const __attribute__((address_space(4))) Params*)__builtin_amdgcn_kernarg_segment_ptr();
        asm volatile("" : "+s"(kp));
        const Params& p = *(const Params*)kp;
        Ctx cx; { int t_ = threadIdx.x, b_ = blockIdx.x, n_ = gridDim.x; asm volatile("" : "+v"(t_)); asm volatile("" : "+s"(b_), "+s"(n_)); cx.tid = t_; cx.bid = b_; cx.nb = n_; }
        unsigned char* ws = p.ws;
        float* XL = p.out; float* XC = (float*)(ws + WS_XC);
        bf16_t* H = (bf16_t*)(ws + WS_H); bf16_t* Y = (bf16_t*)(ws + WS_Y); bf16_t* HID = (bf16_t*)(ws + WS_HID); bf16_t* G = (bf16_t*)(ws + WS_G);
        const unsigned char* wb = ws + ((((ph - 1) / 13) & 1) ? WS_WB2 : WS_WB);
        if (ph == 0) {
#ifndef NO_P0
            phase_modv(cx, p, lds); phase_tables(cx, p); phase_conv(cx, p, 0, lds);
            for (int i = cx.bid * NTHR + cx.tid; i < MC * D / 4; i += cx.nb * NTHR) ((f32x4*)XC)[i] = ((const f32x4*)p.in[2])[i];
#endif
        }
        else {
            const int l = (ph - 1) / 13, k = (ph - 1) % 13;
            const float* modl = (const float*)(ws + WS_MODV) + (size_t)l * 3 * 9216;
            const float* xl_in = l == 0 ? p.in[0] : XL; const float* xc_in = XC;
            if (k == 0 || k == 3 || k == 10) {
#ifndef NO_NORM
                phase_norm(cx, k == 0 ? xl_in : XL, XC, modl, k == 0 ? 0 : (k == 3 ? 3 : 6), k == 0 ? 1 : (k == 3 ? 4 : 7), H, (const float*)(ws + WS_S5Y), k == 0 ? (l > 0 ? 11 : 0) : (k == 3 ? 11 : 8), (l == DEPTH - 1 && k == 10) ? ML : MT);
#endif
            } else if (k == 5) {
                for (int it = cx.bid; it < NA_ITEMS + S5_ITEMS + RET_ITEMS; it += cx.nb) {
                    Ctx cx0 = cx; asm volatile("" : "+v"(cx0.tid)); const Ctx cx = cx0;
#ifdef PROBE_ONLY
                    const int only = dup_done ? PROBE_ONLY : 0;
#else
                    const int only = 0;
#endif
                    if (it < NA_ITEMS) { if ((only == 0 || only == 1) && !(l == DEPTH - 1 && it >= NA_LAT_ITEMS)) {
#ifdef PROBE_NA_STAGE_ONLY
                        na_item(cx, p, l, it, lds, dup_done);
#else
                        na_item(cx, p, l, it, lds);
#endif
                    } }
                    else if (it < NA_ITEMS + S5_ITEMS) { if (only == 0 || only == 2) s5_item<1>(cx, p, l, it - NA_ITEMS, lds); }
                    else { if (only == 0 || only == 3) ret_kv_item(cx, p, l, it - NA_ITEMS - S5_ITEMS, lds); }
                }
            } else if (k == 6) {
                phase_scans(cx, p, l);
                if (l + 1 < DEPTH) phase_conv(cx, p, l + 1, lds);
            } else if (k == 7) {
                for (int it = cx.bid; it < RET_ITEMS + S5_ITEMS; it += cx.nb) {
                    Ctx cx0 = cx; asm volatile("" : "+v"(cx0.tid)); const Ctx cx = cx0;
#ifdef PROBE_ONLY
                    const int only = dup_done ? PROBE_ONLY : 0;
#else
                    const int only = 0;
#endif
                    if (it < RET_ITEMS) { if (only == 0 || only == 1) ret_out_item(cx, p, l, it, lds); }
                    else { if (only == 0 || only == 2) s5_item<2>(cx, p, l, it - RET_ITEMS, lds); }
                }
            } else {
                const bool f_in = (k == 1 || k == 11), f_out = (k == 2 || k == 12);
                const bf16_t* gA = f_in ? H : f_out ? HID : (k == 4 ? H : (k == 8 ? G : Y));
                const size_t wo = k == 1 ? WB_F1IN : k == 11 ? WB_F2IN : k == 2 ? WB_F1OUT : k == 12 ? WB_F2OUT : k == 4 ? WB_WIN : k == 8 ? WB_GLU : WB_WOUT;
                const int gN = f_in ? 2 * DFF : (k == 4 ? INW : (k == 8 ? 512 : D));
                const int gK = f_out ? DFF : (k == 8 ? 256 : D);
                const int etype = f_in ? 0 : (k == 4 ? 2 : (k == 8 ? 1 : 3));
                bf16_t* eO = k == 8 ? Y : HID; const int eldc = k == 4 ? INW : (k == 8 ? D : DFF); const int ecol = k == 8 ? 768 : 0;
                const float* egate = modl + (k == 2 ? 2 : (k == 12 ? 8 : 5)) * 1024;
#ifdef PROBE_DUP_K
                const float ecoef = (k == PROBE_DUP_K && !dup_done) ? 0.f : (k == 9 ? 1.0f : 0.5f);
#else
                const float ecoef = k == 9 ? 1.0f : 0.5f;
#endif

                const float* exin_l = k == 2 ? xl_in : XL;
                const pg8::Gemm g{gA, (const bf16_t*)(wb + wo), MT, gN, gK};
                const pg8::EpiAny E{etype, eldc, ecol, ecoef, eO, exin_l, XL, XC, XC, egate, (float*)(ws + WS_S5Y)};
                pg8::Order S; S.init(g.N, g.K, cx.nb, cx.bid, E.type == 3 ? (g.K == D ? 2 : 4) : 0, (l == DEPTH - 1 && k >= 8) ? 1 : 0);
#ifndef NO_GEMM
                pg8::gemm_phase<pg8::EpiAny, pg8::Order, true, true>(lds, g, S, E, cx.tid);
#endif
            }
        }
        if (ph == 0) grid.sync();
        else { XcdBarrier xb_; xb_.bar = (unsigned*)(ws + WS_DIAG); xb_.x = xb_xcc_id(); xb_.st = bst; xcd_barrier(xb_); }
#ifdef PROBE_DUP_MIX
        if (ph > 0 && (ph - 1) % 13 == 8 && !dup_done) { dup_done = 1; ph -= 4; } else if (ph > 0 && (ph - 1) % 13 == 8) dup_done = 0;
#endif
#ifdef PROBE_DUP_K
        if (ph > 0 && ((ph - 1) % 13 == PROBE_DUP_K) && !dup_done) { dup_done = 1; ph -= 1; } else dup_done = 0;
#endif
    }
}
extern "C" void kernel_launch(void* const* d_in, const int* in_sizes, int n_in, void* d_out, int out_size, void* d_ws, size_t ws_size, hipStream_t stream) {
    static int grid = 0;
    if (grid == 0) {
        if (n_in != 26 || out_size != ML * D || ws_size < WS_END) { fprintf(stderr, "kernel_launch: unexpected shapes: n_in %d out %d ws %zu (need %zu)\n", n_in, out_size, ws_size, (size_t)WS_END); grid = -1; return; }
        int dev = 0, cus = 0, per_cu = 0;
        hipGetDevice(&dev); hipDeviceGetAttribute(&cus, hipDeviceAttributeMultiprocessorCount, dev);
        if (hipFuncSetAttribute((const void*)fwd_mega, hipFuncAttributeMaxDynamicSharedMemorySize, LDS_BYTES) != hipSuccess) { fprintf(stderr, "kernel_launch: hipFuncSetAttribute failed\n"); grid = -1; return; }
        if (hipOccupancyMaxActiveBlocksPerMultiprocessor(&per_cu, (const void*)fwd_mega, NTHR, LDS_BYTES) != hipSuccess || per_cu < 1) { fprintf(stderr, "kernel_launch: occupancy query gave %d\n", per_cu); per_cu = 1; }
        (void)hipGetLastError();
        grid = cus * per_cu;
    }
    if (grid < 0) return;
    Params prm{};
    for (int i = 0; i < 26; ++i) prm.in[i] = (const float*)d_in[i];
    prm.out = (float*)d_out; prm.ws = (unsigned char*)d_ws;
    if (hipMemsetAsync(d_ws, 0, 16384, stream) != hipSuccess) { fprintf(stderr, "kernel_launch: memset of barrier words failed\n"); return; }
    void* args[] = {&prm};
    hipError_t e = hipLaunchCooperativeKernel((const void*)fwd_mega, dim3(grid), dim3(NTHR), args, LDS_BYTES, stream);
    if (e != hipSuccess) fprintf(stderr, "cooperative launch failed: %s (grid %d)\n", hipGetErrorString(e), grid);
}
```
